# Optimizing an MI355X kernel written in HIP

```python
import jax
import jax.numpy as jnp
from jax import lax
import numpy as np

D_MODEL = 1024
BATCH = 4
SEQ = 8192
DEPTH = 1

GRID_W = 64
CTX_LEN = 256
HEAD_DIM = 64
A_Q_HEADS = D_MODEL // (2 * HEAD_DIM)
A_KV_HEADS = A_Q_HEADS // 4
A_REP = A_Q_HEADS // A_KV_HEADS
A_WINDOW = 128
A_BLOCK = 128
A_SPAN = A_BLOCK + 2 * A_WINDOW
B_HEADS = D_MODEL // (2 * HEAD_DIM)
NA_KH = 8
NA_KW = 16
NA_QBW = 16
NA_CSPAN = NA_QBW + NA_KW
A_WIDTH = A_Q_HEADS * HEAD_DIM
A_KV_WIDTH = A_KV_HEADS * HEAD_DIM
B_WIDTH = B_HEADS * HEAD_DIM
MIX_WIDTH = A_WIDTH + B_WIDTH
IN_COLS = A_WIDTH + 2 * A_KV_WIDTH + 3 * B_WIDTH
ROPE_BASE = 10000.0
N_EXPERTS = 256
TOP_K = 8
N_GROUPS = 8
TOPK_GROUPS = 4
EXPERT_DIM = D_MODEL // 4
SHARED_DIM = D_MODEL // 4
ROUTED_SCALE = 2.5
DISPATCH_BLOCK = 128
EPS = 1e-6
NEG_INF = -1e30

kernel_name = 'hybrid_swa_natten_moe_flow_block'


def _rms_norm(x, gain):
    xf = x.astype(jnp.float32)
    y = xf * lax.rsqrt(jnp.mean(xf * xf, axis=-1, keepdims=True) + EPS)
    return (y * gain.astype(jnp.float32)).astype(x.dtype)


def _modulate(h, shift, scale):
    return h * (1 + scale) + shift


def _swiglu(x, w_gate, w_up, w_down):
    return (jax.nn.silu(x @ w_gate) * (x @ w_up)) @ w_down


def _axial_rope(x, row_pos, col_pos):
    quarter = HEAD_DIM // 4
    half = HEAD_DIM // 2
    freqs = ROPE_BASE ** (-jnp.arange(quarter, dtype=jnp.float32) / quarter)

    def rot(xs, pos):
        ang = pos[:, None] * freqs[None, :]
        cos = jnp.cos(ang)[:, None, :]
        sin = jnp.sin(ang)[:, None, :]
        x1 = xs[..., :quarter].astype(jnp.float32)
        x2 = xs[..., quarter:].astype(jnp.float32)
        return jnp.concatenate([x1 * cos - x2 * sin, x1 * sin + x2 * cos], axis=-1)

    out = jnp.concatenate([rot(x[..., :half], row_pos), rot(x[..., half:], col_pos)], axis=-1)
    return out.astype(x.dtype)


def _sink_softmax(s, sink):
    m = jnp.maximum(jnp.max(s, axis=-1, keepdims=True), sink)
    p = jnp.exp(s - m)
    return p / (jnp.sum(p, axis=-1, keepdims=True) + jnp.exp(sink - m))


def _project(h, w_in, q_norm_a, k_norm_a, q_norm_b, k_norm_b):
    z = h @ w_in
    cuts = [A_WIDTH, A_WIDTH + A_KV_WIDTH, A_WIDTH + 2 * A_KV_WIDTH,
            A_WIDTH + 2 * A_KV_WIDTH + B_WIDTH, A_WIDTH + 2 * A_KV_WIDTH + 2 * B_WIDTH]
    qa, ka, va, qb, kb, vb = jnp.split(z, cuts, axis=-1)

    def heads(u):
        return u.reshape(u.shape[:-1] + (-1, HEAD_DIM))

    return (_rms_norm(heads(qa), q_norm_a), _rms_norm(heads(ka), k_norm_a), heads(va),
            _rms_norm(heads(qb), q_norm_b), _rms_norm(heads(kb), k_norm_b), heads(vb))


def _windowed_gqa(q, k, v, k_ctx, v_ctx, sink):
    b, s = q.shape[0], q.shape[1]
    nb = s // A_BLOCK
    scale = HEAD_DIM ** -0.5
    qb = q.reshape(b, nb, A_BLOCK, A_KV_HEADS, A_REP, HEAD_DIM).transpose(1, 0, 2, 3, 4, 5)
    pad = ((0, 0), (A_WINDOW, A_WINDOW), (0, 0), (0, 0))
    kp = jnp.pad(k, pad)
    vp = jnp.pad(v, pad)
    sink_b = sink.astype(jnp.float32).reshape(1, A_KV_HEADS, A_REP, 1, 1)

    def block(args):
        bi, q_blk = args
        start = bi * A_BLOCK
        k_blk = lax.dynamic_slice_in_dim(kp, start, A_SPAN, axis=1)
        v_blk = lax.dynamic_slice_in_dim(vp, start, A_SPAN, axis=1)
        q_pos = start + jnp.arange(A_BLOCK)
        k_pos = start - A_WINDOW + jnp.arange(A_SPAN)
        mask = ((jnp.abs(q_pos[:, None] - k_pos[None, :]) <= A_WINDOW)
                & (k_pos >= 0)[None, :] & (k_pos < s)[None, :])
        s_loc = jnp.einsum('bqgrd,bkgd->bgrqk', q_blk, k_blk).astype(jnp.float32) * scale
        s_loc = jnp.where(mask, s_loc, NEG_INF)
        s_ctx = jnp.einsum('bqgrd,bkgd->bgrqk', q_blk, k_ctx).astype(jnp.float32) * scale
        p = _sink_softmax(jnp.concatenate([s_loc, s_ctx], axis=-1), sink_b)
        o = (jnp.einsum('bgrqk,bkgd->bqgrd', p[..., :A_SPAN], v_blk.astype(jnp.float32))
             + jnp.einsum('bgrqk,bkgd->bqgrd', p[..., A_SPAN:], v_ctx.astype(jnp.float32)))
        return o.reshape(b, A_BLOCK, A_WIDTH).astype(q.dtype)

    out = lax.map(block, (jnp.arange(nb), qb))
    return out.transpose(1, 0, 2, 3).reshape(b, s, A_WIDTH)


def _na_column_layout():
    ncb = GRID_W // NA_QBW
    n = np.arange(ncb)
    cs = np.clip(n * NA_QBW - NA_KW // 2, 0, GRID_W - NA_CSPAN)
    col_idx = cs[:, None] + np.arange(NA_CSPAN)[None, :]
    q_col = n[:, None] * NA_QBW + np.arange(NA_QBW)[None, :]
    ws = np.clip(q_col - NA_KW // 2, 0, GRID_W - NA_KW)[..., None]
    k_col = col_idx[:, None, :]
    col_mask = (k_col >= ws) & (k_col < ws + NA_KW)
    dc_idx = np.clip(k_col - q_col[..., None], -(NA_KW - 1), NA_KW - 1) + (NA_KW - 1)
    return col_idx, col_mask, dc_idx


def _neighbourhood_attention(q, k, v, k_ctx, v_ctx, rpb):
    b, s, h, d = q.shape
    rows = s // GRID_W
    kh = min(NA_KH, rows)
    ncb = GRID_W // NA_QBW
    col_idx, col_mask, dc_idx = _na_column_layout()
    scale = HEAD_DIM ** -0.5
    qg = q.reshape(b, rows, ncb, NA_QBW, h, d).transpose(1, 0, 2, 3, 4, 5)
    kg = k.reshape(b, rows, GRID_W, h, d)
    vg = v.reshape(b, rows, GRID_W, h, d)
    rpb = rpb.astype(jnp.float32)
    n_loc = kh * NA_CSPAN

    def row_block(args):
        r, q_row = args
        rs = jnp.clip(r - kh // 2, 0, rows - kh)
        k_reg = lax.dynamic_slice_in_dim(kg, rs, kh, axis=1)[:, :, col_idx]
        v_reg = lax.dynamic_slice_in_dim(vg, rs, kh, axis=1)[:, :, col_idx]
        s_loc = jnp.einsum('bnqhd,bknchd->bhnqkc', q_row, k_reg).astype(jnp.float32) * scale
        dr = rs + jnp.arange(kh) - r + (NA_KH - 1)
        bias = rpb[:, dr[:, None, None, None], dc_idx[None]].transpose(0, 2, 3, 1, 4)
        s_loc = jnp.where(col_mask[:, :, None, :], s_loc + bias[None], NEG_INF)
        s_loc = s_loc.reshape(b, h, ncb, NA_QBW, n_loc)
        s_ctx = jnp.einsum('bnqhd,blhd->bhnql', q_row, k_ctx).astype(jnp.float32) * scale
        p = jax.nn.softmax(jnp.concatenate([s_loc, s_ctx], axis=-1), axis=-1)
        v_loc = v_reg.transpose(0, 2, 1, 3, 4, 5).reshape(b, ncb, n_loc, h, d)
        o = (jnp.einsum('bhnqj,bnjhd->bnqhd', p[..., :n_loc], v_loc.astype(jnp.float32))
             + jnp.einsum('bhnql,blhd->bnqhd', p[..., n_loc:], v_ctx.astype(jnp.float32)))
        return o.reshape(b, GRID_W, h * d).astype(q.dtype)

    out = lax.map(row_block, (jnp.arange(rows), qg))
    return out.transpose(1, 0, 2, 3).reshape(b, s, h * d)


def _context_attention(q, k, v, sink):
    b, l, h, d = q.shape
    g = k.shape[2]
    r = h // g
    qg = q.reshape(b, l, g, r, d)
    s = jnp.einsum('bqgrd,bkgd->bgrqk', qg, k).astype(jnp.float32) * (HEAD_DIM ** -0.5)
    if sink is None:
        p = jax.nn.softmax(s, axis=-1)
    else:
        p = _sink_softmax(s, sink.astype(jnp.float32).reshape(1, g, r, 1, 1))
    o = jnp.einsum('bgrqk,bkgd->bqgrd', p, v.astype(jnp.float32))
    return o.reshape(b, l, h * d).astype(q.dtype)


def _merge(o_a, o_b, out_norm_a, out_norm_b, w_out):
    return jnp.concatenate([_rms_norm(o_a, out_norm_a), _rms_norm(o_b, out_norm_b)], axis=-1) @ w_out


def _moe(h, w_router, router_bias, we_gate, we_up, we_down, ws_gate, ws_up, ws_down):
    shape = h.shape
    hf = h.reshape(-1, shape[-1])
    n = hf.shape[0]
    scores = jax.nn.sigmoid((hf @ w_router).astype(jnp.float32))
    sel = scores + router_bias.astype(jnp.float32)
    grouped = sel.reshape(n, N_GROUPS, N_EXPERTS // N_GROUPS)
    group_score = jnp.sum(lax.top_k(grouped, 2)[0], axis=-1)
    _, top_groups = lax.top_k(group_score, TOPK_GROUPS)
    group_mask = jnp.sum(jax.nn.one_hot(top_groups, N_GROUPS, dtype=jnp.float32), axis=1) > 0
    expert_mask = jnp.repeat(group_mask, N_EXPERTS // N_GROUPS, axis=1)
    _, top_idx = lax.top_k(jnp.where(expert_mask, sel, NEG_INF), TOP_K)
    top_s = jnp.take_along_axis(scores, top_idx, axis=1)
    gates = top_s / jnp.sum(top_s, axis=-1, keepdims=True) * ROUTED_SCALE
    t = DISPATCH_BLOCK
    n_assign = n * TOP_K
    n_blocks = -(-n_assign // t) + N_EXPERTS
    e_flat = top_idx.reshape(-1)
    t_flat = jnp.repeat(jnp.arange(n, dtype=jnp.int32), TOP_K)
    g_flat = gates.reshape(-1)
    order = jnp.argsort(e_flat)
    e_sorted = e_flat[order]
    counts = jnp.bincount(e_flat, length=N_EXPERTS)
    starts = jnp.cumsum(counts) - counts
    padded = (counts + t - 1) // t * t
    pends = jnp.cumsum(padded)
    pstarts = pends - padded
    dest = pstarts[e_sorted] + jnp.arange(n_assign) - starts[e_sorted]
    tok_buf = jnp.zeros((n_blocks * t,), jnp.int32).at[dest].set(t_flat[order])
    gate_buf = jnp.zeros((n_blocks * t,), jnp.float32).at[dest].set(g_flat[order])
    block_expert = jnp.minimum(jnp.searchsorted(pends, jnp.arange(n_blocks) * t, side='right'),
                               N_EXPERTS - 1)

    def body(bi, acc):
        tok = lax.dynamic_slice_in_dim(tok_buf, bi * t, t)
        g = lax.dynamic_slice_in_dim(gate_buf, bi * t, t)
        e = block_expert[bi]
        y = _swiglu(hf[tok], we_gate[e], we_up[e], we_down[e])
        return acc.at[tok].add((y.astype(jnp.float32) * g[:, None]).astype(acc.dtype))

    routed = lax.fori_loop(0, n_blocks, body, jnp.zeros_like(hf))
    out = routed + _swiglu(hf, ws_gate, ws_up, ws_down)
    return out.reshape(shape)


def setup_inputs(seed: int = 0) -> dict:
    key = jax.random.key(seed)
    ks = jax.random.split(key, 26)

    def nrm(k, shape, scale):
        return jax.random.normal(k, shape, jnp.float32) * scale

    d = D_MODEL
    return {
        'x': nrm(ks[0], (BATCH, SEQ, d), 1.0),
        'c': nrm(ks[1], (BATCH, d), 1.0),
        'ctx': nrm(ks[2], (BATCH, CTX_LEN, d), 1.0),
        'c_ctx': nrm(ks[3], (d,), 1.0),
        'w_ada': nrm(ks[4], (DEPTH, d, 6 * d), 0.5 * d ** -0.5),
        'b_ada': nrm(ks[5], (DEPTH, 6 * d), 0.02),
        'norm1': 1.0 + nrm(ks[6], (DEPTH, d), 0.02),
        'norm2': 1.0 + nrm(ks[7], (DEPTH, d), 0.02),
        'w_in': nrm(ks[8], (DEPTH, d, IN_COLS), d ** -0.5),
        'q_norm_a': 1.0 + nrm(ks[9], (DEPTH, HEAD_DIM), 0.02),
        'k_norm_a': 1.0 + nrm(ks[10], (DEPTH, HEAD_DIM), 0.02),
        'q_norm_b': 1.0 + nrm(ks[11], (DEPTH, HEAD_DIM), 0.02),
        'k_norm_b': 1.0 + nrm(ks[12], (DEPTH, HEAD_DIM), 0.02),
        'sink_a': nrm(ks[13], (DEPTH, A_Q_HEADS), 0.5),
        'rpb_b': nrm(ks[14], (DEPTH, B_HEADS, 2 * NA_KH - 1, 2 * NA_KW - 1), 0.1),
        'out_norm_a': 1.0 + nrm(ks[15], (DEPTH, A_WIDTH), 0.02),
        'out_norm_b': 1.0 + nrm(ks[16], (DEPTH, B_WIDTH), 0.02),
        'w_out': nrm(ks[17], (DEPTH, MIX_WIDTH, d), MIX_WIDTH ** -0.5),
        'w_router': nrm(ks[18], (DEPTH, d, N_EXPERTS), d ** -0.5),
        'router_bias': nrm(ks[19], (DEPTH, N_EXPERTS), 0.01),
        'we_gate': nrm(ks[20], (DEPTH, N_EXPERTS, d, EXPERT_DIM), d ** -0.5),
        'we_up': nrm(ks[21], (DEPTH, N_EXPERTS, d, EXPERT_DIM), d ** -0.5),
        'we_down': nrm(ks[22], (DEPTH, N_EXPERTS, EXPERT_DIM, d), EXPERT_DIM ** -0.5),
        'ws_gate': nrm(ks[23], (DEPTH, d, SHARED_DIM), d ** -0.5),
        'ws_up': nrm(ks[24], (DEPTH, d, SHARED_DIM), d ** -0.5),
        'ws_down': nrm(ks[25], (DEPTH, SHARED_DIM, d), SHARED_DIM ** -0.5),
    }


def reference(x, c, ctx, c_ctx, w_ada, b_ada, norm1, norm2, w_in, q_norm_a, k_norm_a, q_norm_b,
              k_norm_b, sink_a, rpb_b, out_norm_a, out_norm_b, w_out, w_router, router_bias,
              we_gate, we_up, we_down, ws_gate, ws_up, ws_down):
    s = x.shape[1]
    t = jnp.arange(s)
    row_pos = (t // GRID_W).astype(jnp.float32)
    col_pos = (t % GRID_W).astype(jnp.float32)
    for i in range(DEPTH):
        mod = jax.nn.silu(c) @ w_ada[i] + b_ada[i]
        sh1, sc1, g1, sh2, sc2, g2 = [m[:, None, :] for m in jnp.split(mod, 6, axis=-1)]
        mod_c = jax.nn.silu(c_ctx) @ w_ada[i] + b_ada[i]
        sh1c, sc1c, g1c, sh2c, sc2c, g2c = jnp.split(mod_c, 6, axis=-1)

        h = _modulate(_rms_norm(x, norm1[i]), sh1, sc1)
        hc = _modulate(_rms_norm(ctx, norm1[i]), sh1c, sc1c)
        qa, ka, va, qb, kb, vb = _project(h, w_in[i], q_norm_a[i], k_norm_a[i], q_norm_b[i], k_norm_b[i])
        qa_c, ka_c, va_c, qb_c, kb_c, vb_c = _project(hc, w_in[i], q_norm_a[i], k_norm_a[i],
                                                      q_norm_b[i], k_norm_b[i])
        qa = _axial_rope(qa, row_pos, col_pos)
        ka = _axial_rope(ka, row_pos, col_pos)
        o_a = _windowed_gqa(qa, ka, va, ka_c, va_c, sink_a[i])
        o_b = _neighbourhood_attention(qb, kb, vb, kb_c, vb_c, rpb_b[i])
        x = x + g1 * _merge(o_a, o_b, out_norm_a[i], out_norm_b[i], w_out[i])

        h2 = _modulate(_rms_norm(x, norm2[i]), sh2, sc2)
        x = x + g2 * _moe(h2, w_router[i], router_bias[i], we_gate[i], we_up[i], we_down[i],
                          ws_gate[i], ws_up[i], ws_down[i])

        if i < DEPTH - 1:
            oc_a = _context_attention(qa_c, ka_c, va_c, sink_a[i])
            oc_b = _context_attention(qb_c, kb_c, vb_c, None)
            ctx = ctx + g1c * _merge(oc_a, oc_b, out_norm_a[i], out_norm_b[i], w_out[i])
            hc2 = _modulate(_rms_norm(ctx, norm2[i]), sh2c, sc2c)
            ctx = ctx + g2c * _moe(hc2, w_router[i], router_bias[i], we_gate[i], we_up[i], we_down[i],
                                   ws_gate[i], ws_up[i], ws_down[i])
    return x
```

```cpp
#include <hip/hip_runtime.h>
#include <hip/hip_cooperative_groups.h>
#include <cstdio>
#include <cstdint>
namespace cg = cooperative_groups;

typedef unsigned short bf16_t;
typedef short bf16x8 __attribute__((ext_vector_type(8)));
typedef float f32x4 __attribute__((ext_vector_type(4)));
typedef __bf16 bf16v2 __attribute__((ext_vector_type(2)));
typedef float f32v2 __attribute__((ext_vector_type(2)));

constexpr int D = 1024, NB = 4, SEQ = 8192, CTXL = 256, TT = SEQ + CTXL, MR = NB * TT, NLAT = NB * SEQ;
constexpr int INC = 2304, NE = 256;
constexpr float EPS = 1e-6f;
constexpr float L2E = 1.4426950408889634f;

struct Params {
    const float *x, *c, *ctx, *c_ctx, *w_ada, *b_ada, *norm1, *norm2, *w_in, *qna, *kna, *qnb, *knb, *sink, *rpb, *ona, *onb,
        *w_out, *w_router, *rbias, *we_gate, *we_up, *we_down, *ws_gate, *ws_up, *ws_down;
    float* out;
    float* mod; float2* rope; int* gcount; float* gain_out;
    bf16_t *h, *qa, *ka, *vta, *qb, *kb, *vtb, *o;
    float *osq, *st2; bf16_t* h2; float* logits; float* gates; int* lists; bf16_t* act; bf16_t* y;
};

__device__ __forceinline__ unsigned pack2(float a, float b) {
    f32v2 v = {a, b};
    bf16v2 r = __builtin_convertvector(v, bf16v2);
    return __builtin_bit_cast(unsigned, r);
}
__device__ __forceinline__ uint2 pack4(f32x4 v) { uint2 r; r.x = pack2(v[0], v[1]); r.y = pack2(v[2], v[3]); return r; }
__device__ __forceinline__ int swz(int row, int ch) { return row * 128 + ((ch ^ ((row >> 1) & 7)) << 4); }
__device__ __forceinline__ float wave_sum(float v) {
#pragma unroll
    for (int o = 32; o >= 1; o >>= 1) v += __shfl_xor(v, o);
    return v;
}
__device__ __forceinline__ f32x4 mfma16(bf16x8 a, bf16x8 b, f32x4 c) { return __builtin_amdgcn_mfma_f32_16x16x32_bf16(a, b, c, 0, 0, 0); }

struct ARows { const bf16_t* p[4]; };

template <int WM, int WN, int MF, int NF, bool BGAIN>
__device__ __forceinline__ void gemm_mainloop(unsigned char* smem, const ARows& ar, const float* bp, int ldb, const float* gainp, int nk,
                                              f32x4 (&acc)[MF][NF], int mid_it, const float (&midscale)[MF]) {
    const int tid = threadIdx.x, lane = tid & 63, wid = tid >> 6, l15 = lane & 15, gq = lane >> 4;
    const int wm = wid / WN, wn = wid % WN;
    const int a_row = tid >> 3, a_ch = tid & 7, b_ng = tid & 31, b_kg = tid >> 5;
    uint4 ra0, ra1, ra2, ra3; float4 rb0, rb1, rb2, rb3, rb4, rb5, rb6, rb7; float4 g0 = {1.f, 1.f, 1.f, 1.f}, g1 = {1.f, 1.f, 1.f, 1.f};
#pragma unroll
    for (int m = 0; m < MF; ++m)
#pragma unroll
        for (int n = 0; n < NF; ++n) acc[m][n] = (f32x4){0.f, 0.f, 0.f, 0.f};
    const int arow = wm * MF * 16 + l15, asw = (arow >> 1) & 7;
    const int aoff0 = arow * 128 + ((gq ^ asw) << 4), aoff1 = arow * 128 + (((4 + gq) ^ asw) << 4);
    const int brow = wn * NF * 16 + l15, bsw = (brow >> 1) & 7;
    const int boff0 = 16384 + brow * 128 + ((gq ^ bsw) << 4), boff1 = 16384 + brow * 128 + (((4 + gq) ^ bsw) << 4);
    const int asto = a_row * 128 + ((a_ch ^ ((a_row >> 1) & 7)) << 4);
    const int bst0 = 16384 + (b_ng * 4) * 128 + ((b_kg ^ ((2 * b_ng) & 7)) << 4);
    const int bst1 = 16384 + (b_ng * 4 + 2) * 128 + ((b_kg ^ ((2 * b_ng + 1) & 7)) << 4);

#define GLOAD(it) do { \
    ra0 = *(const uint4*)(ar.p[0] + (it) * 64); ra1 = *(const uint4*)(ar.p[1] + (it) * 64); ra2 = *(const uint4*)(ar.p[2] + (it) * 64); ra3 = *(const uint4*)(ar.p[3] + (it) * 64); \
    { const float* bq_ = bp + (size_t)((it) * 64) * ldb; \
      rb0 = *(const float4*)(bq_); rb1 = *(const float4*)(bq_ + (size_t)ldb); rb2 = *(const float4*)(bq_ + (size_t)2 * ldb); rb3 = *(const float4*)(bq_ + (size_t)3 * ldb); \
      rb4 = *(const float4*)(bq_ + (size_t)4 * ldb); rb5 = *(const float4*)(bq_ + (size_t)5 * ldb); rb6 = *(const float4*)(bq_ + (size_t)6 * ldb); rb7 = *(const float4*)(bq_ + (size_t)7 * ldb); } \
    if (BGAIN) { g0 = *(const float4*)(gainp + (it) * 64); g1 = *(const float4*)(gainp + (it) * 64 + 4); } } while (0)
#define GMUL(v, g) do { v.x *= (g); v.y *= (g); v.z *= (g); v.w *= (g); } while (0)
#define LSTORE(buf) do { \
    *(uint4*)((buf) + asto) = ra0; *(uint4*)((buf) + asto + 4096) = ra1; *(uint4*)((buf) + asto + 8192) = ra2; *(uint4*)((buf) + asto + 12288) = ra3; \
    if (BGAIN) { GMUL(rb0, g0.x); GMUL(rb1, g0.y); GMUL(rb2, g0.z); GMUL(rb3, g0.w); GMUL(rb4, g1.x); GMUL(rb5, g1.y); GMUL(rb6, g1.z); GMUL(rb7, g1.w); } \
    { uint4 w; \
      w.x = pack2(rb0.x, rb1.x); w.y = pack2(rb2.x, rb3.x); w.z = pack2(rb4.x, rb5.x); w.w = pack2(rb6.x, rb7.x); *(uint4*)((buf) + bst0) = w; \
      w.x = pack2(rb0.y, rb1.y); w.y = pack2(rb2.y, rb3.y); w.z = pack2(rb4.y, rb5.y); w.w = pack2(rb6.y, rb7.y); *(uint4*)((buf) + bst0 + 128) = w; \
      w.x = pack2(rb0.z, rb1.z); w.y = pack2(rb2.z, rb3.z); w.z = pack2(rb4.z, rb5.z); w.w = pack2(rb6.z, rb7.z); *(uint4*)((buf) + bst1) = w; \
      w.x = pack2(rb0.w, rb1.w); w.y = pack2(rb2.w, rb3.w); w.z = pack2(rb4.w, rb5.w); w.w = pack2(rb6.w, rb7.w); *(uint4*)((buf) + bst1 + 128) = w; } } while (0)

    GLOAD(0);
    LSTORE(smem);
    __syncthreads();
#pragma unroll 1
    for (int it = 0; it < nk; ++it) {
        unsigned char* cur = smem + (it & 1) * 32768;
        unsigned char* nxt = smem + ((it + 1) & 1) * 32768;
        if (it + 1 < nk) GLOAD(it + 1);
#pragma unroll
        for (int ks = 0; ks < 2; ++ks) {
            bf16x8 af[MF], bfr[NF];
#pragma unroll
            for (int m = 0; m < MF; ++m) af[m] = *(const bf16x8*)(cur + (ks ? aoff1 : aoff0) + m * 2048);
#pragma unroll
            for (int n = 0; n < NF; ++n) bfr[n] = *(const bf16x8*)(cur + (ks ? boff1 : boff0) + n * 2048);
#pragma unroll
            for (int m = 0; m < MF; ++m)
#pragma unroll
                for (int n = 0; n < NF; ++n) acc[m][n] = mfma16(bfr[n], af[m], acc[m][n]);
        }
        if (it == mid_it) {
#pragma unroll
            for (int m = 0; m < MF; ++m)
#pragma unroll
                for (int n = 0; n < NF; ++n) acc[m][n] *= midscale[m];
        }
        if (it + 1 < nk) LSTORE(nxt);
        __syncthreads();
    }
#undef GLOAD
#undef LSTORE
#undef GMUL
}

__device__ void phase0(const Params& p, unsigned char* smem) {
    const int tid = threadIdx.x;
    for (int u = blockIdx.x; u < 97; u += gridDim.x) {
        if (u < 96) {
            float* sc = (float*)smem;
            for (int i = tid; i < 5 * 1024; i += 256) {
                const int r = i >> 10, k = i & 1023;
                const float v = r < 4 ? p.c[r * 1024 + k] : p.c_ctx[k];
                sc[i] = v / (1.f + expf(-v));
            }
            __syncthreads();
            const int cg4 = tid & 15, ks = tid >> 4;
            const int n0 = u * 64 + cg4 * 4;
            float4 a0 = {0, 0, 0, 0}, a1 = a0, a2 = a0, a3 = a0, a4 = a0;
            for (int kk = 0; kk < 64; ++kk) {
                const int k = ks * 64 + kk;
                const float4 w = *(const float4*)(p.w_ada + (size_t)k * 6144 + n0);
                const float s0 = sc[k], s1 = sc[1024 + k], s2 = sc[2048 + k], s3 = sc[3072 + k], s4 = sc[4096 + k];
                a0.x += s0 * w.x; a0.y += s0 * w.y; a0.z += s0 * w.z; a0.w += s0 * w.w;
                a1.x += s1 * w.x; a1.y += s1 * w.y; a1.z += s1 * w.z; a1.w += s1 * w.w;
                a2.x += s2 * w.x; a2.y += s2 * w.y; a2.z += s2 * w.z; a2.w += s2 * w.w;
                a3.x += s3 * w.x; a3.y += s3 * w.y; a3.z += s3 * w.z; a3.w += s3 * w.w;
                a4.x += s4 * w.x; a4.y += s4 * w.y; a4.z += s4 * w.z; a4.w += s4 * w.w;
            }
            float4* red = (float4*)(smem + 20480);
            red[(ks * 5 + 0) * 16 + cg4] = a0; red[(ks * 5 + 1) * 16 + cg4] = a1; red[(ks * 5 + 2) * 16 + cg4] = a2;
            red[(ks * 5 + 3) * 16 + cg4] = a3; red[(ks * 5 + 4) * 16 + cg4] = a4;
            __syncthreads();
            if (tid < 80) {
                const int r = tid >> 4, g = tid & 15;
                float4 s = {0, 0, 0, 0};
                for (int k2 = 0; k2 < 16; ++k2) { const float4 v = red[(k2 * 5 + r) * 16 + g]; s.x += v.x; s.y += v.y; s.z += v.z; s.w += v.w; }
                const int n = u * 64 + g * 4;
                const float4 bb = *(const float4*)(p.b_ada + n);
                s.x += bb.x; s.y += bb.y; s.z += bb.z; s.w += bb.w;
                *(float4*)(p.mod + r * 6144 + n) = s;
            }
            __syncthreads();
        } else {
            for (int idx = tid; idx < 2048; idx += 256) {
                const int pos = idx >> 4, i = idx & 15;
                double f = 1.0;
                for (int q = 0; q < i; ++q) f *= 0.56234132519034908;
                const double ang = (double)pos * f;
                const double twopi = 6.283185307179586476925286766559;
                const double nn = rint(ang / twopi);
                const double r = ang - nn * twopi, r2 = r * r;
                double s = r, term = r, cc = 1.0, termc = 1.0;
                for (int q = 1; q <= 14; ++q) {
                    term *= -r2 / (double)((2 * q) * (2 * q + 1)); s += term;
                    termc *= -r2 / (double)((2 * q - 1) * (2 * q)); cc += termc;
                }
                p.rope[idx] = make_float2((float)cc, (float)s);
            }
            if (tid < NE) p.gcount[tid] = 0;
            for (int k = tid; k < 1024; k += 256) p.gain_out[k] = k < 512 ? p.ona[k] : p.onb[k - 512];
        }
    }
}

__device__ void phase1a(const Params& p) {
    const int lane = threadIdx.x & 63, wid = threadIdx.x >> 6;
    const int nw = gridDim.x * 4;
    for (int R = blockIdx.x * 4 + wid; R < MR; R += nw) {
        const int b = R / TT, t = R - b * TT;
        const float* src = t < SEQ ? p.x + (size_t)(b * SEQ + t) * D : p.ctx + (size_t)(b * CTXL + t - SEQ) * D;
        const float* md = p.mod + (t < SEQ ? b : 4) * 6144;
        float4 v[4]; float ss = 0.f;
#pragma unroll
        for (int i = 0; i < 4; ++i) { v[i] = *(const float4*)(src + i * 256 + lane * 4); ss += v[i].x * v[i].x + v[i].y * v[i].y + v[i].z * v[i].z + v[i].w * v[i].w; }
        ss = wave_sum(ss);
        const float rstd = 1.0f / sqrtf(ss * (1.0f / 1024.0f) + EPS);
#pragma unroll
        for (int i = 0; i < 4; ++i) {
            const int k = i * 256 + lane * 4;
            const float4 n1 = *(const float4*)(p.norm1 + k), sh = *(const float4*)(md + k), sc = *(const float4*)(md + 1024 + k);
            f32x4 o;
            o[0] = (v[i].x * rstd * n1.x) * (1.f + sc.x) + sh.x; o[1] = (v[i].y * rstd * n1.y) * (1.f + sc.y) + sh.y;
            o[2] = (v[i].z * rstd * n1.z) * (1.f + sc.z) + sh.z; o[3] = (v[i].w * rstd * n1.w) * (1.f + sc.w) + sh.w;
            *(uint2*)(p.h + (size_t)R * D + k) = pack4(o);
        }
    }
}

__device__ void phase1b(const Params& p, unsigned char* smem) {
    const int tid = threadIdx.x, lane = tid & 63, wid = tid >> 6, l15 = lane & 15, gq = lane >> 4;
    const int wm = wid >> 1, wn = wid & 1;
    const int a_row = tid >> 3, a_ch = tid & 7, b_ng = tid & 31, b_kg = tid >> 5;
    const int nunits = 264 * 18;
    for (int u = blockIdx.x; u < nunits; u += gridDim.x) {
        const int mt = u / 18, nt = u - mt * 18;
        const int b = mt / 66, t0 = (mt - b * 66) * 128;
        const bool isctx = t0 >= SEQ;
        const bool isq = (nt < 4) || (nt >= 6 && nt < 10);
        if (isctx && isq) continue;
        ARows ar;
#pragma unroll
        for (int i = 0; i < 4; ++i) ar.p[i] = p.h + (size_t)(mt * 128 + a_row + 32 * i) * D + a_ch * 8;
        const float* bp = p.w_in + (size_t)(b_kg * 8) * INC + nt * 128 + b_ng * 4;
        f32x4 acc[4][4];
        const float ms[4] = {1.f, 1.f, 1.f, 1.f};
        gemm_mainloop<2, 2, 4, 4, false>(smem, ar, bp, INC, nullptr, 16, acc, -1, ms);
        const bool isv = (nt == 5) || (nt >= 14);
        if (!isv) {
            const float* gain; bf16_t* dst; int ld; int head; bool rope;
            if (nt < 4) { gain = p.qna; head = nt * 2 + wn; dst = p.qa; ld = 512; rope = true; }
            else if (nt == 4) { gain = p.kna; head = wn; dst = p.ka; ld = 128; rope = true; }
            else if (nt < 10) { gain = p.qnb; head = (nt - 6) * 2 + wn; dst = p.qb; ld = 512; rope = false; }
            else { gain = p.knb; head = (nt - 10) * 2 + wn; dst = p.kb; ld = 512; rope = false; }
            if (isctx) rope = false;
            f32x4 gv[4];
#pragma unroll
            for (int n = 0; n < 4; ++n) { const float4 g = *(const float4*)(gain + n * 16 + gq * 4); gv[n] = (f32x4){g.x, g.y, g.z, g.w}; }
#pragma unroll
            for (int m = 0; m < 4; ++m) {
                float ss = 0.f;
#pragma unroll
                for (int n = 0; n < 4; ++n) ss += acc[m][n][0] * acc[m][n][0] + acc[m][n][1] * acc[m][n][1] + acc[m][n][2] * acc[m][n][2] + acc[m][n][3] * acc[m][n][3];
                ss += __shfl_xor(ss, 16); ss += __shfl_xor(ss, 32);
                const float rstd = 1.0f / sqrtf(ss * (1.0f / 64.0f) + EPS);
                f32x4 y[4];
#pragma unroll
                for (int n = 0; n < 4; ++n) y[n] = acc[m][n] * rstd * gv[n];
                const int tl = t0 + wm * 64 + m * 16 + l15;
                if (rope) {
                    const int rp = tl >> 6, cp = tl & 63;
                    const float4 ra0 = *(const float4*)(p.rope + rp * 16 + gq * 4), ra1 = *(const float4*)(p.rope + rp * 16 + gq * 4 + 2);
                    const float4 ca0 = *(const float4*)(p.rope + cp * 16 + gq * 4), ca1 = *(const float4*)(p.rope + cp * 16 + gq * 4 + 2);
                    const float rc[4] = {ra0.x, ra0.z, ra1.x, ra1.z}, rs[4] = {ra0.y, ra0.w, ra1.y, ra1.w};
                    const float cc[4] = {ca0.x, ca0.z, ca1.x, ca1.z}, cs[4] = {ca0.y, ca0.w, ca1.y, ca1.w};
#pragma unroll
                    for (int r = 0; r < 4; ++r) {
                        const float x1 = y[0][r], x2 = y[1][r];
                        y[0][r] = x1 * rc[r] - x2 * rs[r]; y[1][r] = x1 * rs[r] + x2 * rc[r];
                        const float x3 = y[2][r], x4 = y[3][r];
                        y[2][r] = x3 * cc[r] - x4 * cs[r]; y[3][r] = x3 * cs[r] + x4 * cc[r];
                    }
                }
                bf16_t* rowp = dst + (size_t)(b * TT + tl) * ld + head * 64 + gq * 4;
#pragma unroll
                for (int n = 0; n < 4; ++n) *(uint2*)(rowp + n * 16) = pack4(y[n]);
            }
        } else {
            bf16_t* vb;
            if (nt == 5) vb = p.vta + (size_t)((b * 2 + wn) * 64) * TT;
            else vb = p.vtb + (size_t)((b * 8 + (nt - 14) * 2 + wn) * 64) * TT;
#pragma unroll
            for (int m = 0; m < 4; ++m) {
                const int tl = t0 + wm * 64 + m * 16 + l15;
#pragma unroll
                for (int n = 0; n < 4; ++n) {
                    const uint2 w = pack4(acc[m][n]);
                    bf16_t* q = vb + (size_t)(n * 16 + gq * 4) * TT + tl;
                    q[0] = (bf16_t)(w.x & 0xffff); q[TT] = (bf16_t)(w.x >> 16); q[2 * TT] = (bf16_t)(w.y & 0xffff); q[3 * TT] = (bf16_t)(w.y >> 16);
                }
            }
        }
    }
}

template <int NQ, int NKF, int MODE>
__device__ __forceinline__ void attn_tile(const unsigned char* kb_, const unsigned char* vb_, int koff, const bf16x8 (&qf)[NQ][2],
                                          float (&mrun)[NQ], float (&lpart)[NQ], f32x4 (&o)[NQ][4], int l15, int gq,
                                          int qpos0, int kpos0, int qcol, int wstart, const float* biasrow) {
    f32x4 s[NQ][NKF];
    const int krow = koff + l15, ksw = (krow >> 1) & 7;
    const int kad0 = krow * 128 + ((gq ^ ksw) << 4), kad1 = krow * 128 + (((4 + gq) ^ ksw) << 4);
#pragma unroll
    for (int q = 0; q < NQ; ++q)
#pragma unroll
        for (int kf = 0; kf < NKF; ++kf) s[q][kf] = (f32x4){0.f, 0.f, 0.f, 0.f};
#pragma unroll
    for (int kf = 0; kf < NKF; ++kf)
#pragma unroll
        for (int ks = 0; ks < 2; ++ks) {
            const bf16x8 kfr = *(const bf16x8*)(kb_ + (ks ? kad1 : kad0) + kf * 2048);
#pragma unroll
            for (int q = 0; q < NQ; ++q) s[q][kf] = mfma16(kfr, qf[q][ks], s[q][kf]);
        }
    bf16x8 pb[NQ][NKF / 2];
#pragma unroll
    for (int q = 0; q < NQ; ++q) {
        float tmax = -1e30f;
#pragma unroll
        for (int kf = 0; kf < NKF; ++kf)
#pragma unroll
            for (int r = 0; r < 4; ++r) {
                float xv = s[q][kf][r] * 0.125f;
                bool valid = true;
                if (MODE == 1) { const int d = (qpos0 + q * 16) - (kpos0 + kf * 16 + gq * 4 + r); valid = (d <= 128) && (d >= -128); }
                if (MODE == 2) {
                    const int kc = koff + kf * 16 + gq * 4 + r; valid = (kc >= wstart) && (kc < wstart + 16);
                    int bi = kc - qcol + 15; bi = bi < 0 ? 0 : (bi > 30 ? 30 : bi);
                    xv += biasrow[bi];
                }
                xv = valid ? xv : -1e30f;
                s[q][kf][r] = xv; tmax = fmaxf(tmax, xv);
            }
        tmax = fmaxf(tmax, __shfl_xor(tmax, 16)); tmax = fmaxf(tmax, __shfl_xor(tmax, 32));
        const float mnew = fmaxf(mrun[q], tmax);
        const float alpha = __builtin_amdgcn_exp2f((mrun[q] - mnew) * L2E);
        mrun[q] = mnew;
        float ls = 0.f;
#pragma unroll
        for (int kf = 0; kf < NKF; ++kf)
#pragma unroll
            for (int r = 0; r < 4; ++r) {
                const float xv = s[q][kf][r];
                const float pv = (xv > -5e29f) ? __builtin_amdgcn_exp2f((xv - mnew) * L2E) : 0.f;
                ls += pv; s[q][kf][r] = pv;
            }
        lpart[q] = lpart[q] * alpha + ls;
#pragma unroll
        for (int df = 0; df < 4; ++df) o[q][df] *= alpha;
#pragma unroll
        for (int t = 0; t < NKF / 2; ++t) {
            uint4 w; w.x = pack2(s[q][2 * t][0], s[q][2 * t][1]); w.y = pack2(s[q][2 * t][2], s[q][2 * t][3]);
            w.z = pack2(s[q][2 * t + 1][0], s[q][2 * t + 1][1]); w.w = pack2(s[q][2 * t + 1][2], s[q][2 * t + 1][3]);
            pb[q][t] = __builtin_bit_cast(bf16x8, w);
        }
    }
#pragma unroll
    for (int t = 0; t < NKF / 2; ++t) {
        const int vsw = (l15 >> 1) & 7;
        const int ko = koff + 32 * t + 4 * gq, ko2 = ko + 16;
        const int vlo = l15 * 128 + (((ko >> 3) ^ vsw) << 4) + ((ko & 4) << 1);
        const int vhi = l15 * 128 + (((ko2 >> 3) ^ vsw) << 4) + ((ko2 & 4) << 1);
#pragma unroll
        for (int df = 0; df < 4; ++df) {
            const uint2 lo = *(const uint2*)(vb_ + vlo + df * 2048);
            const uint2 hi = *(const uint2*)(vb_ + vhi + df * 2048);
            uint4 w; w.x = lo.x; w.y = lo.y; w.z = hi.x; w.w = hi.y;
            const bf16x8 vfr = __builtin_bit_cast(bf16x8, w);
#pragma unroll
            for (int q = 0; q < NQ; ++q) o[q][df] = mfma16(vfr, pb[q][t], o[q][df]);
        }
    }
}

template <bool ISA>
__device__ __forceinline__ void attn_unit(const Params& p, unsigned char* smem, int b, int hh, int blk) {
    constexpr int NQ = ISA ? 2 : 1;
    const int tid = threadIdx.x, lane = tid & 63, wid = tid >> 6, l15 = lane & 15, gq = lane >> 4;
    int nl, tbase;
    if (ISA) {
        const int start = blk * 128;
        const int j0 = start >= 128 ? 0 : 2, j1 = (start + 256 <= SEQ) ? 6 : 4;
        nl = j1 - j0; tbase = start - 128 + 64 * j0;
    } else {
        int rs = blk - 4; rs = rs < 0 ? 0 : (rs > 120 ? 120 : rs);
        nl = 8; tbase = rs * 64;
    }
    const int ntile = nl + 4;
    const bf16_t* kbase; const bf16_t* vbase; int ldk;
    if (ISA) { const int g = hh >> 2; kbase = p.ka + (size_t)(b * TT) * 128 + g * 64; ldk = 128; vbase = p.vta + (size_t)((b * 2 + g) * 64) * TT; }
    else { kbase = p.kb + (size_t)(b * TT) * 512 + hh * 64; ldk = 512; vbase = p.vtb + (size_t)((b * 8 + hh) * 64) * TT; }
    float* rpbl = (float*)(smem + 32768);
    if (!ISA) { for (int i = tid; i < 465; i += 256) rpbl[i] = p.rpb[hh * 465 + i]; }
    const int qt0 = ISA ? blk * 128 + wid * 32 : blk * 64 + wid * 16;
    bf16x8 qf[NQ][2];
    {
        const bf16_t* qsrc = ISA ? p.qa : p.qb;
#pragma unroll
        for (int q = 0; q < NQ; ++q)
#pragma unroll
            for (int ks = 0; ks < 2; ++ks)
                qf[q][ks] = *(const bf16x8*)(qsrc + (size_t)(b * TT + qt0 + q * 16 + l15) * 512 + hh * 64 + ks * 32 + gq * 8);
    }
    float mrun[NQ], lpart[NQ]; f32x4 o[NQ][4];
#pragma unroll
    for (int q = 0; q < NQ; ++q) {
        if (ISA) { mrun[q] = p.sink[hh]; lpart[q] = gq == 0 ? 1.f : 0.f; } else { mrun[q] = -1e30f; lpart[q] = 0.f; }
#pragma unroll
        for (int df = 0; df < 4; ++df) o[q][df] = (f32x4){0.f, 0.f, 0.f, 0.f};
    }
    const int qcol = wid * 16 + l15;
    int cs = wid * 16 - 8; cs = cs < 0 ? 0 : (cs > 32 ? 32 : cs);
    int wstart = qcol - 8; wstart = wstart < 0 ? 0 : (wstart > 48 ? 48 : wstart);
    const int r0 = tid >> 3, ch = tid & 7;
    uint4 kr0, kr1, vr0, vr1;
#define ALOAD(ti) do { const int t0_ = (ti) < nl ? tbase + 64 * (ti) : SEQ + 64 * ((ti) - nl); \
    kr0 = *(const uint4*)(kbase + (size_t)(t0_ + r0) * ldk + ch * 8); kr1 = *(const uint4*)(kbase + (size_t)(t0_ + r0 + 32) * ldk + ch * 8); \
    vr0 = *(const uint4*)(vbase + (size_t)(r0) * TT + t0_ + ch * 8); vr1 = *(const uint4*)(vbase + (size_t)(r0 + 32) * TT + t0_ + ch * 8); } while (0)
#define ASTORE(bi) do { *(uint4*)(smem + (bi) * 8192 + swz(r0, ch)) = kr0; *(uint4*)(smem + (bi) * 8192 + swz(r0 + 32, ch)) = kr1; \
    *(uint4*)(smem + 16384 + (bi) * 8192 + swz(r0, ch)) = vr0; *(uint4*)(smem + 16384 + (bi) * 8192 + swz(r0 + 32, ch)) = vr1; } while (0)
    ALOAD(0);
    ASTORE(0);
    __syncthreads();
#pragma unroll 1
    for (int ti = 0; ti < ntile; ++ti) {
        if (ti + 1 < ntile) ALOAD(ti + 1);
        const unsigned char* kb_ = smem + (ti & 1) * 8192;
        const unsigned char* vb_ = smem + 16384 + (ti & 1) * 8192;
        if (ti < nl) {
            const int t0 = tbase + 64 * ti;
            if (ISA) {
                const bool skip = (t0 > qt0 + 31 + 128) || (t0 + 63 < qt0 - 128);
                if (!skip) attn_tile<NQ, 4, 1>(kb_, vb_, 0, qf, mrun, lpart, o, l15, gq, qt0 + l15, t0, 0, 0, nullptr);
            } else {
                const int kr_ = t0 >> 6;
                const int dr = kr_ - blk + 7;
                attn_tile<NQ, 2, 2>(kb_, vb_, cs, qf, mrun, lpart, o, l15, gq, 0, 0, qcol, wstart, rpbl + dr * 31);
            }
        } else {
            attn_tile<NQ, 4, 0>(kb_, vb_, 0, qf, mrun, lpart, o, l15, gq, 0, 0, 0, 0, nullptr);
        }
        if (ti + 1 < ntile) ASTORE((ti + 1) & 1);
        __syncthreads();
    }
#undef ALOAD
#undef ASTORE
#pragma unroll
    for (int q = 0; q < NQ; ++q) {
        float lt = lpart[q]; lt += __shfl_xor(lt, 16); lt += __shfl_xor(lt, 32);
        const float inv = 1.0f / lt;
        float ssq = 0.f;
#pragma unroll
        for (int df = 0; df < 4; ++df) { o[q][df] *= inv; ssq += o[q][df][0] * o[q][df][0] + o[q][df][1] * o[q][df][1] + o[q][df][2] * o[q][df][2] + o[q][df][3] * o[q][df][3]; }
        ssq += __shfl_xor(ssq, 16); ssq += __shfl_xor(ssq, 32);
        const size_t lr = (size_t)b * SEQ + qt0 + q * 16 + l15;
        if (gq == 0) p.osq[lr * 16 + (ISA ? hh : 8 + hh)] = ssq;
        bf16_t* op = p.o + lr * 1024 + (ISA ? 0 : 512) + hh * 64 + gq * 4;
#pragma unroll
        for (int df = 0; df < 4; ++df) *(uint2*)(op + df * 16) = pack4(o[q][df]);
    }
}

__device__ void phase2(const Params& p, unsigned char* smem) {
    const int nunits = 2048 + 4096;
    for (int u = blockIdx.x; u < nunits; u += gridDim.x) {
        if (u < 2048) {
            const int hh = u & 7, blk = (u >> 3) & 63, b = u >> 9;
            attn_unit<true>(p, smem, b, hh, blk);
        } else {
            const int v = u - 2048;
            const int blk = v & 127, hh = (v >> 7) & 7, b = v >> 10;
            attn_unit<false>(p, smem, b, hh, blk);
        }
    }
}

__device__ void phase3(const Params& p, unsigned char* smem) {
    const int tid = threadIdx.x, lane = tid & 63, wid = tid >> 6, l15 = lane & 15, gq = lane >> 4;
    const int wm = wid >> 1, wn = wid & 1;
    const int a_row = tid >> 3, a_ch = tid & 7, b_ng = tid & 31, b_kg = tid >> 5;
    const int nunits = 256 * 8;
    for (int u = blockIdx.x; u < nunits; u += gridDim.x) {
        const int mt = u >> 3, nt = u & 7;
        const int b = mt >> 6;
        ARows ar;
#pragma unroll
        for (int i = 0; i < 4; ++i) ar.p[i] = p.o + (size_t)(mt * 128 + a_row + 32 * i) * D + a_ch * 8;
        const float* bp = p.w_out + (size_t)(b_kg * 8) * D + nt * 128 + b_ng * 4;
        const float* gp = p.gain_out + b_kg * 8;
        float ms[4], fs[4];
#pragma unroll
        for (int m = 0; m < 4; ++m) {
            const size_t row = (size_t)mt * 128 + wm * 64 + m * 16 + l15;
            const float4 s0 = *(const float4*)(p.osq + row * 16), s1 = *(const float4*)(p.osq + row * 16 + 4);
            const float4 s2 = *(const float4*)(p.osq + row * 16 + 8), s3 = *(const float4*)(p.osq + row * 16 + 12);
            const float sa = (s0.x + s0.y + s0.z + s0.w) + (s1.x + s1.y + s1.z + s1.w);
            const float sb = (s2.x + s2.y + s2.z + s2.w) + (s3.x + s3.y + s3.z + s3.w);
            const float ra = 1.0f / sqrtf(sa * (1.0f / 512.0f) + EPS), rb = 1.0f / sqrtf(sb * (1.0f / 512.0f) + EPS);
            ms[m] = ra / rb; fs[m] = rb;
        }
        f32x4 acc[4][4];
        gemm_mainloop<2, 2, 4, 4, true>(smem, ar, bp, D, gp, 16, acc, 7, ms);
        const float* g1p = p.mod + b * 6144 + 2048;
#pragma unroll
        for (int m = 0; m < 4; ++m) {
            const size_t row = (size_t)mt * 128 + wm * 64 + m * 16 + l15;
            float ss = 0.f;
#pragma unroll
            for (int n = 0; n < 4; ++n) {
                const int col = nt * 128 + wn * 64 + n * 16 + gq * 4;
                const float4 xv = *(const float4*)(p.x + row * D + col);
                const float4 g1 = *(const float4*)(g1p + col);
                float4 r;
                r.x = xv.x + g1.x * (acc[m][n][0] * fs[m]); r.y = xv.y + g1.y * (acc[m][n][1] * fs[m]);
                r.z = xv.z + g1.z * (acc[m][n][2] * fs[m]); r.w = xv.w + g1.w * (acc[m][n][3] * fs[m]);
                ss += r.x * r.x + r.y * r.y + r.z * r.z + r.w * r.w;
                *(float4*)(p.out + row * D + col) = r;
            }
            ss += __shfl_xor(ss, 16); ss += __shfl_xor(ss, 32);
            if (gq == 0) p.st2[row * 16 + nt * 2 + wn] = ss;
        }
    }
}

__device__ void phase4a(const Params& p) {
    const int lane = threadIdx.x & 63, wid = threadIdx.x >> 6;
    const int nw = gridDim.x * 4;
    for (int R = blockIdx.x * 4 + wid; R < NLAT; R += nw) {
        const int b = R >> 13;
        const float* md = p.mod + b * 6144;
        float sv = lane < 16 ? p.st2[(size_t)R * 16 + lane] : 0.f;
        sv = wave_sum(sv);
        const float rstd = 1.0f / sqrtf(sv * (1.0f / 1024.0f) + EPS);
        const float* src = p.out + (size_t)R * D;
#pragma unroll
        for (int i = 0; i < 4; ++i) {
            const int k = i * 256 + lane * 4;
            const float4 v = *(const float4*)(src + k);
            const float4 n2 = *(const float4*)(p.norm2 + k), sh = *(const float4*)(md + 3072 + k), sc = *(const float4*)(md + 4096 + k);
            f32x4 o;
            o[0] = (v.x * rstd * n2.x) * (1.f + sc.x) + sh.x; o[1] = (v.y * rstd * n2.y) * (1.f + sc.y) + sh.y;
            o[2] = (v.z * rstd * n2.z) * (1.f + sc.z) + sh.z; o[3] = (v.w * rstd * n2.w) * (1.f + sc.w) + sh.w;
            *(uint2*)(p.h2 + (size_t)R * D + k) = pack4(o);
        }
    }
}

__device__ __forceinline__ float silu_f(float v) { return v / (1.f + __expf(-v)); }

template <class SlotF>
__device__ __forceinline__ void swiglu_unit(unsigned char* smem, const ARows& ar, const float* wg, const float* wu, int j, bf16_t* act, SlotF slotf) {
    const int tid = threadIdx.x, lane = tid & 63, wid = tid >> 6, l15 = lane & 15, gq = lane >> 4;
    const int b_ng = tid & 31, b_kg = tid >> 5;
    const int n0 = b_ng * 4;
    const float* bp = (n0 < 64 ? wg + j * 64 + n0 : wu + j * 64 + (n0 - 64)) + (size_t)(b_kg * 8) * 256;
    f32x4 acc[2][8];
    const float ms[2] = {1.f, 1.f};
    gemm_mainloop<4, 1, 2, 8, false>(smem, ar, bp, 256, nullptr, 16, acc, -1, ms);
#pragma unroll
    for (int m = 0; m < 2; ++m) {
        const int rowl = wid * 32 + m * 16 + l15;
        const long slot = slotf(rowl);
        if (slot >= 0) {
            bf16_t* dst = act + (size_t)slot * 256 + j * 64 + gq * 4;
#pragma unroll
            for (int n = 0; n < 4; ++n) {
                f32x4 v;
#pragma unroll
                for (int r = 0; r < 4; ++r) v[r] = silu_f(acc[m][n][r]) * acc[m][n + 4][r];
                *(uint2*)(dst + n * 16) = pack4(v);
            }
        }
    }
}

__device__ void router_unit(const Params& p, unsigned char* smem, int mt) {
    const int tid = threadIdx.x, lane = tid & 63, wid = tid >> 6, l15 = lane & 15, gq = lane >> 4;
    const int wm = wid >> 1, wn = wid & 1;
    const int a_row = tid >> 3, a_ch = tid & 7, b_ng = tid & 31, b_kg = tid >> 5;
    ARows ar;
#pragma unroll
    for (int i = 0; i < 4; ++i) ar.p[i] = p.h2 + (size_t)(mt * 128 + a_row + 32 * i) * D + a_ch * 8;
#pragma unroll 1
    for (int nt = 0; nt < 2; ++nt) {
        const float* bp = p.w_router + (size_t)(b_kg * 8) * 256 + nt * 128 + b_ng * 4;
        f32x4 acc[4][4];
        const float ms[4] = {1.f, 1.f, 1.f, 1.f};
        gemm_mainloop<2, 2, 4, 4, false>(smem, ar, bp, 256, nullptr, 16, acc, -1, ms);
#pragma unroll
        for (int m = 0; m < 4; ++m) {
            const size_t row = (size_t)mt * 128 + wm * 64 + m * 16 + l15;
#pragma unroll
            for (int n = 0; n < 4; ++n) {
                float4 v = {acc[m][n][0], acc[m][n][1], acc[m][n][2], acc[m][n][3]};
                *(float4*)(p.logits + row * 256 + nt * 128 + wn * 64 + n * 16 + gq * 4) = v;
            }
        }
    }
    int* lcnt = (int*)smem;
    int* lbase = (int*)(smem + 1024);
    int* sel_e = (int*)(smem + 2048);
    int* sel_p = (int*)(smem + 2048 + 4096);
    __syncthreads();
    lcnt[tid] = 0;
    __syncthreads();
    const float4 bias4 = *(const float4*)(p.rbias + lane * 4);
#pragma unroll 1
    for (int tl = wid * 32; tl < wid * 32 + 32; ++tl) {
        const size_t tok = (size_t)mt * 128 + tl;
        const float4 lg = *(const float4*)(p.logits + tok * 256 + lane * 4);
        const float s0 = 1.f / (1.f + expf(-lg.x)), s1 = 1.f / (1.f + expf(-lg.y)), s2 = 1.f / (1.f + expf(-lg.z)), s3 = 1.f / (1.f + expf(-lg.w));
        float c0 = s0 + bias4.x, c1 = s1 + bias4.y, c2 = s2 + bias4.z, c3 = s3 + bias4.w;
        float a = fmaxf(c0, c1), bmin = fminf(c0, c1), cmx = fmaxf(c2, c3), dmin = fminf(c2, c3);
        float t1 = fmaxf(a, cmx), t2 = fmaxf(fminf(a, cmx), fmaxf(bmin, dmin));
#pragma unroll
        for (int off = 1; off <= 4; off <<= 1) {
            const float o1 = __shfl_xor(t1, off), o2 = __shfl_xor(t2, off);
            const float n1 = fmaxf(t1, o1), n2 = fmaxf(fminf(t1, o1), fmaxf(t2, o2));
            t1 = n1; t2 = n2;
        }
        const float gs = t1 + t2;
        const int g = lane >> 3;
        int rank = 0;
#pragma unroll
        for (int g2 = 0; g2 < 8; ++g2) { const float og = __shfl(gs, g2 * 8); rank += (og > gs || (og == gs && g2 < g)) ? 1 : 0; }
        if (rank >= 4) { c0 = -1e30f; c1 = -1e30f; c2 = -1e30f; c3 = -1e30f; }
        float tsum = 0.f; float mys = 0.f; int mye = 0;
#pragma unroll
        for (int k = 0; k < 8; ++k) {
            float bv = c0; int bi = lane * 4;
            if (c1 > bv) { bv = c1; bi = lane * 4 + 1; }
            if (c2 > bv) { bv = c2; bi = lane * 4 + 2; }
            if (c3 > bv) { bv = c3; bi = lane * 4 + 3; }
#pragma unroll
            for (int off = 32; off >= 1; off >>= 1) {
                const float ov = __shfl_xor(bv, off); const int oi = __shfl_xor(bi, off);
                if (ov > bv || (ov == bv && oi < bi)) { bv = ov; bi = oi; }
            }
            const int wl = bi >> 2, wi = bi & 3;
            const float sv_l = wi == 0 ? s0 : (wi == 1 ? s1 : (wi == 2 ? s2 : s3));
            const float sv = __shfl(sv_l, wl);
            if (lane == wl) { if (wi == 0) c0 = -INFINITY; else if (wi == 1) c1 = -INFINITY; else if (wi == 2) c2 = -INFINITY; else c3 = -INFINITY; }
            tsum += sv;
            if (lane == k) { mys = sv; mye = bi; }
        }
        if (lane < 8) {
            p.gates[tok * 8 + lane] = mys / tsum * 2.5f;
            const int pos = atomicAdd(&lcnt[mye], 1);
            sel_e[tl * 8 + lane] = mye; sel_p[tl * 8 + lane] = pos;
        }
    }
    __syncthreads();
    { const int cnt = lcnt[tid]; lbase[tid] = cnt > 0 ? atomicAdd(&p.gcount[tid], cnt) : 0; }
    __syncthreads();
    for (int i = tid; i < 1024; i += 256) {
        const int e = sel_e[i], pos = sel_p[i];
        const int tl = i >> 3, k = i & 7;
        p.lists[(size_t)e * NLAT + lbase[e] + pos] = (mt * 128 + tl) * 8 + k;
    }
    __syncthreads();
}

__device__ void phase4b(const Params& p, unsigned char* smem) {
    const int tid = threadIdx.x;
    const int a_row = tid >> 3, a_ch = tid & 7;
    const int nunits = 256 + 1024;
    for (int u = blockIdx.x; u < nunits; u += gridDim.x) {
        if (u < 256) router_unit(p, smem, u);
        else {
            const int v = u - 256, mt = v >> 2, j = v & 3;
            ARows ar;
#pragma unroll
            for (int i = 0; i < 4; ++i) ar.p[i] = p.h2 + (size_t)(mt * 128 + a_row + 32 * i) * D + a_ch * 8;
            swiglu_unit(smem, ar, p.ws_gate, p.ws_up, j, p.act, [&](int rowl) -> long { return (long)NLAT * 8 + mt * 128 + rowl; });
        }
    }
}

struct XMap { int x, lb, nlb; int* pref; };

__device__ __forceinline__ XMap xmap_build(const Params& p, unsigned char* smem_tail) {
    XMap m; m.x = blockIdx.x & 7; m.lb = blockIdx.x >> 3; m.nlb = (gridDim.x - m.x + 7) >> 3; m.pref = (int*)smem_tail;
    __syncthreads();
    if (threadIdx.x == 0) {
        int s = 0; m.pref[0] = 0;
        for (int i = 0; i < 32; ++i) { const int c = p.gcount[m.x + 8 * i]; s += (c + 127) >> 7; m.pref[i + 1] = s; }
    }
    __syncthreads();
    return m;
}
__device__ __forceinline__ void xmap_find(const XMap& m, int tix, int& e, int& ti) {
    int lo = 0;
#pragma unroll
    for (int step = 16; step >= 1; step >>= 1) if (m.pref[lo + step] <= tix) lo += step;
    e = m.x + 8 * lo; ti = tix - m.pref[lo];
}

__device__ void phase5a(const Params& p, unsigned char* smem) {
    const int tid = threadIdx.x, lane = tid & 63, wid = tid >> 6, l15 = lane & 15, gq = lane >> 4;
    const int wm = wid >> 1, wn = wid & 1;
    const int a_row = tid >> 3, a_ch = tid & 7, b_ng = tid & 31, b_kg = tid >> 5;
    XMap xm = xmap_build(p, smem + 65536);
    const int nloc = xm.pref[32] * 4;
    for (int lu = xm.lb; lu < nloc; lu += xm.nlb) {
        int e, ti; xmap_find(xm, lu >> 2, e, ti);
        const int j = lu & 3;
        const int cnt = p.gcount[e];
        const int* lst = p.lists + (size_t)e * NLAT + ti * 128;
        const int nrow = cnt - ti * 128;
        ARows ar;
#pragma unroll
        for (int i = 0; i < 4; ++i) {
            const int r = a_row + 32 * i;
            const int slot = r < nrow ? lst[r] : 0;
            ar.p[i] = p.h2 + (size_t)(slot >> 3) * D + a_ch * 8;
        }
        swiglu_unit(smem, ar, p.we_gate + (size_t)e * 262144, p.we_up + (size_t)e * 262144, j, p.act,
                    [&](int rowl) -> long { return rowl < nrow ? (long)lst[rowl] : -1L; });
    }
    const int nsh = 256 * 8;
    for (int u = blockIdx.x; u < nsh; u += gridDim.x) {
        const int mt = u >> 3, nt = u & 7, b = mt >> 6;
        ARows ar;
#pragma unroll
        for (int i = 0; i < 4; ++i) ar.p[i] = p.act + ((size_t)NLAT * 8 + mt * 128 + a_row + 32 * i) * 256 + a_ch * 8;
        const float* bp = p.ws_down + (size_t)(b_kg * 8) * D + nt * 128 + b_ng * 4;
        f32x4 acc[4][4];
        const float ms[4] = {1.f, 1.f, 1.f, 1.f};
        gemm_mainloop<2, 2, 4, 4, false>(smem, ar, bp, D, nullptr, 4, acc, -1, ms);
        const float* g2p = p.mod + b * 6144 + 5120;
#pragma unroll
        for (int m = 0; m < 4; ++m) {
            const size_t row = (size_t)mt * 128 + wm * 64 + m * 16 + l15;
#pragma unroll
            for (int n = 0; n < 4; ++n) {
                const int col = nt * 128 + wn * 64 + n * 16 + gq * 4;
                float4 xv = *(const float4*)(p.out + row * D + col);
                const float4 g2 = *(const float4*)(g2p + col);
                xv.x += g2.x * acc[m][n][0]; xv.y += g2.y * acc[m][n][1]; xv.z += g2.z * acc[m][n][2]; xv.w += g2.w * acc[m][n][3];
                *(float4*)(p.out + row * D + col) = xv;
            }
        }
    }
}

__device__ void phase5b(const Params& p, unsigned char* smem) {
    const int tid = threadIdx.x, lane = tid & 63, wid = tid >> 6, l15 = lane & 15, gq = lane >> 4;
    const int wm = wid >> 1, wn = wid & 1;
    const int a_row = tid >> 3, a_ch = tid & 7, b_ng = tid & 31, b_kg = tid >> 5;
    XMap xm = xmap_build(p, smem + 65536);
    const int nloc = xm.pref[32] * 8;
    for (int lu = xm.lb; lu < nloc; lu += xm.nlb) {
        int e, ti; xmap_find(xm, lu >> 3, e, ti);
        const int nt = lu & 7;
        const int cnt = p.gcount[e];
        const int* lst = p.lists + (size_t)e * NLAT + ti * 128;
        const int nrow = cnt - ti * 128;
        ARows ar;
#pragma unroll
        for (int i = 0; i < 4; ++i) {
            const int r = a_row + 32 * i;
            const int slot = r < nrow ? lst[r] : 0;
            ar.p[i] = p.act + (size_t)slot * 256 + a_ch * 8;
        }
        const float* bp = p.we_down + (size_t)e * 262144 + (size_t)(b_kg * 8) * D + nt * 128 + b_ng * 4;
        f32x4 acc[4][4];
        const float ms[4] = {1.f, 1.f, 1.f, 1.f};
        gemm_mainloop<2, 2, 4, 4, false>(smem, ar, bp, D, nullptr, 4, acc, -1, ms);
#pragma unroll
        for (int m = 0; m < 4; ++m) {
            const int rowl = wm * 64 + m * 16 + l15;
            if (rowl < nrow) {
                const int slot = lst[rowl];
                bf16_t* dst = p.y + (size_t)slot * D + nt * 128 + wn * 64 + gq * 4;
#pragma unroll
                for (int n = 0; n < 4; ++n) *(uint2*)(dst + n * 16) = pack4(acc[m][n]);
            }
        }
    }
}

__device__ void phase6(const Params& p) {
    const int lane = threadIdx.x & 63, wid = threadIdx.x >> 6;
    const int nw = gridDim.x * 4;
    for (int R = blockIdx.x * 4 + wid; R < NLAT; R += nw) {
        const int b = R >> 13;
        const float* g2p = p.mod + b * 6144 + 5120;
        const float4 ga = *(const float4*)(p.gates + (size_t)R * 8), gb = *(const float4*)(p.gates + (size_t)R * 8 + 4);
        const float gk[8] = {ga.x, ga.y, ga.z, ga.w, gb.x, gb.y, gb.z, gb.w};
#pragma unroll
        for (int i = 0; i < 4; ++i) {
            const int col = i * 256 + lane * 4;
            float s0 = 0.f, s1 = 0.f, s2 = 0.f, s3 = 0.f;
#pragma unroll
            for (int k = 0; k < 8; ++k) {
                const uint2 w = *(const uint2*)(p.y + ((size_t)R * 8 + k) * D + col);
                s0 += gk[k] * __uint_as_float(w.x << 16); s1 += gk[k] * __uint_as_float(w.x & 0xffff0000u);
                s2 += gk[k] * __uint_as_float(w.y << 16); s3 += gk[k] * __uint_as_float(w.y & 0xffff0000u);
            }
            float4 xv = *(const float4*)(p.out + (size_t)R * D + col);
            const float4 g2 = *(const float4*)(g2p + col);
            xv.x += g2.x * s0; xv.y += g2.y * s1; xv.z += g2.z * s2; xv.w += g2.w * s3;
            *(float4*)(p.out + (size_t)R * D + col) = xv;
        }
    }
}

constexpr size_t al256(size_t v) { return (v + 255) & ~(size_t)255; }
constexpr size_t OFF_MOD = 0;
constexpr size_t OFF_ROPE = OFF_MOD + al256(5 * 6144 * 4);
constexpr size_t OFF_GCOUNT = OFF_ROPE + al256(2048 * 8);
constexpr size_t OFF_GAIN = OFF_GCOUNT + al256(256 * 4);
constexpr size_t OFF_OSQ = OFF_GAIN + al256(1024 * 4);
constexpr size_t OFF_ST2 = OFF_OSQ + al256((size_t)NLAT * 16 * 4);
constexpr size_t OFF_H2 = OFF_ST2 + al256((size_t)NLAT * 16 * 4);
constexpr size_t OFF_GATES = OFF_H2 + al256((size_t)NLAT * D * 2);
constexpr size_t OFF_LISTS = OFF_GATES + al256((size_t)NLAT * 8 * 4);
constexpr size_t OFF_ACT = OFF_LISTS + al256((size_t)NE * NLAT * 4);
constexpr size_t OFF_UNION = OFF_ACT + al256((size_t)NLAT * 9 * 256 * 2);
constexpr size_t OFF_Y = OFF_UNION;
constexpr size_t OFF_H = OFF_UNION;
constexpr size_t OFF_QA = OFF_H + al256((size_t)MR * D * 2);
constexpr size_t OFF_KA = OFF_QA + al256((size_t)MR * 512 * 2);
constexpr size_t OFF_VTA = OFF_KA + al256((size_t)MR * 128 * 2);
constexpr size_t OFF_QB = OFF_VTA + al256((size_t)NB * 2 * 64 * TT * 2);
constexpr size_t OFF_KB = OFF_QB + al256((size_t)MR * 512 * 2);
constexpr size_t OFF_VTB = OFF_KB + al256((size_t)MR * 512 * 2);
constexpr size_t OFF_O = OFF_VTB + al256((size_t)NB * 8 * 64 * TT * 2);
constexpr size_t OFF_LOGITS = OFF_O + al256((size_t)NLAT * D * 2);
constexpr size_t END_A = OFF_LOGITS + al256((size_t)NLAT * 256 * 4);
constexpr size_t END_Y = OFF_Y + (size_t)NLAT * 8 * D * 2;
constexpr size_t WS_NEED = END_A > END_Y ? END_A : END_Y;

struct KArgs { const float* in[26]; float* out; unsigned char* ws; };

__device__ __forceinline__ Params make_params(const KArgs& a) {
    Params p;
    p.x = a.in[0]; p.c = a.in[1]; p.ctx = a.in[2]; p.c_ctx = a.in[3]; p.w_ada = a.in[4]; p.b_ada = a.in[5]; p.norm1 = a.in[6]; p.norm2 = a.in[7];
    p.w_in = a.in[8]; p.qna = a.in[9]; p.kna = a.in[10]; p.qnb = a.in[11]; p.knb = a.in[12]; p.sink = a.in[13]; p.rpb = a.in[14]; p.ona = a.in[15];
    p.onb = a.in[16]; p.w_out = a.in[17]; p.w_router = a.in[18]; p.rbias = a.in[19]; p.we_gate = a.in[20]; p.we_up = a.in[21]; p.we_down = a.in[22];
    p.ws_gate = a.in[23]; p.ws_up = a.in[24]; p.ws_down = a.in[25];
    p.out = a.out;
    unsigned char* w = a.ws;
    p.mod = (float*)(w + OFF_MOD); p.rope = (float2*)(w + OFF_ROPE); p.gcount = (int*)(w + OFF_GCOUNT); p.gain_out = (float*)(w + OFF_GAIN);
    p.osq = (float*)(w + OFF_OSQ); p.st2 = (float*)(w + OFF_ST2); p.h2 = (bf16_t*)(w + OFF_H2); p.gates = (float*)(w + OFF_GATES);
    p.lists = (int*)(w + OFF_LISTS); p.act = (bf16_t*)(w + OFF_ACT); p.y = (bf16_t*)(w + OFF_Y);
    p.h = (bf16_t*)(w + OFF_H); p.qa = (bf16_t*)(w + OFF_QA); p.ka = (bf16_t*)(w + OFF_KA); p.vta = (bf16_t*)(w + OFF_VTA);
    p.qb = (bf16_t*)(w + OFF_QB); p.kb = (bf16_t*)(w + OFF_KB); p.vtb = (bf16_t*)(w + OFF_VTB); p.o = (bf16_t*)(w + OFF_O);
    p.logits = (float*)(w + OFF_LOGITS);
    return p;
}

__global__ void __launch_bounds__(256, 2) mk_fwd(KArgs ka) {
    cg::grid_group grid = cg::this_grid();
    __shared__ __attribute__((aligned(16))) unsigned char smem[65536 + 256];
    const Params p = make_params(ka);
    phase0(p, smem);
    grid.sync();
    phase1a(p);
    grid.sync();
    phase1b(p, smem);
    grid.sync();
    phase2(p, smem);
    grid.sync();
    phase3(p, smem);
    grid.sync();
    phase4a(p);
    grid.sync();
    phase4b(p, smem);
    grid.sync();
    phase5a(p, smem);
    grid.sync();
    phase5b(p, smem);
    grid.sync();
    phase6(p);
}

extern "C" void kernel_launch(void* const* d_in, const int* in_sizes, int n_in,
                              void* d_out, int out_size, void* d_ws, size_t ws_size,
                              hipStream_t stream) {
    static int grid_blocks = 0;
    if (!grid_blocks) {
        int dev = 0, cus = 0, per_cu = 0;
        (void)hipGetDevice(&dev);
        (void)hipDeviceGetAttribute(&cus, hipDeviceAttributeMultiprocessorCount, dev);
        (void)hipOccupancyMaxActiveBlocksPerMultiprocessor(&per_cu, mk_fwd, 256, 0);
        if (per_cu > 2) per_cu = 2;
        if (per_cu < 1) per_cu = 1;
        grid_blocks = cus * per_cu;
    }
    if (WS_NEED > ws_size) { fprintf(stderr, "workspace too small: need %zu have %zu\n", (size_t)WS_NEED, ws_size); return; }
    KArgs a{};
    for (int i = 0; i < 26; ++i) a.in[i] = (const float*)d_in[i];
    a.out = (float*)d_out; a.ws = (unsigned char*)d_ws;
    void* args[] = {&a};
    hipError_t e = hipLaunchCooperativeKernel((void*)mk_fwd, dim3(grid_blocks), dim3(256), args, 0, stream);
    if (e != hipSuccess) fprintf(stderr, "cooperative launch failed: %s (grid %d)\n", hipGetErrorString(e), grid_blocks);
}
```

```cpp
#include <hip/hip_runtime.h>
#include <hip/hip_cooperative_groups.h>
#include <cstdio>
#include <cstdint>
namespace cg = cooperative_groups;

typedef unsigned short bf16_t;
typedef short bf16x8 __attribute__((ext_vector_type(8)));
typedef float f32x4 __attribute__((ext_vector_type(4)));
typedef __bf16 bf16v2 __attribute__((ext_vector_type(2)));
typedef float f32v2 __attribute__((ext_vector_type(2)));

constexpr int D = 1024, NB = 4, SEQ = 8192, CTXL = 256, TT = SEQ + CTXL, MR = NB * TT, NLAT = NB * SEQ;
constexpr int INC = 2304, NE = 256;
constexpr float EPS = 1e-6f;
constexpr float L2E = 1.4426950408889634f;

struct Params {
    const float *x, *c, *ctx, *c_ctx, *w_ada, *b_ada, *norm1, *norm2, *w_in, *qna, *kna, *qnb, *knb, *sink, *rpb, *ona, *onb,
        *w_out, *w_router, *rbias, *we_gate, *we_up, *we_down, *ws_gate, *ws_up, *ws_down;
    float* out;
    float* mod; float2* rope; int* gcount; float* gain_out;
    bf16_t *h, *qa, *ka, *vta, *qb, *kb, *vtb, *o;
    float *osq, *st2; bf16_t* h2; float* logits; float* gates; int* lists; bf16_t* act; bf16_t* y;
};

__device__ __forceinline__ unsigned pack2(float a, float b) {
    f32v2 v = {a, b};
    bf16v2 r = __builtin_convertvector(v, bf16v2);
    return __builtin_bit_cast(unsigned, r);
}
__device__ __forceinline__ uint2 pack4(f32x4 v) { uint2 r; r.x = pack2(v[0], v[1]); r.y = pack2(v[2], v[3]); return r; }
__device__ __forceinline__ int swz(int row, int ch) { return row * 128 + ((ch ^ ((row >> 1) & 7)) << 4); }
__device__ __forceinline__ float wave_sum(float v) {
#pragma unroll
    for (int o = 32; o >= 1; o >>= 1) v += __shfl_xor(v, o);
    return v;
}
__device__ __forceinline__ f32x4 mfma16(bf16x8 a, bf16x8 b, f32x4 c) { return __builtin_amdgcn_mfma_f32_16x16x32_bf16(a, b, c, 0, 0, 0); }

struct ARows { const bf16_t* p[4]; };

template <int WM, int WN, int MF, int NF, bool BGAIN>
__device__ __forceinline__ void gemm_mainloop(unsigned char* smem, const ARows& ar, const float* bp, int ldb, const float* gainp, int nk,
                                              f32x4 (&acc)[MF][NF], int mid_it, const float (&midscale)[MF]) {
    const int tid = threadIdx.x, lane = tid & 63, wid = tid >> 6, l15 = lane & 15, gq = lane >> 4;
    const int wm = wid / WN, wn = wid % WN;
    const int a_row = tid >> 3, a_ch = tid & 7, b_ng = tid & 31, b_kg = tid >> 5;
    uint4 ra0, ra1, ra2, ra3; float4 rb0, rb1, rb2, rb3, rb4, rb5, rb6, rb7; float4 g0 = {1.f, 1.f, 1.f, 1.f}, g1 = {1.f, 1.f, 1.f, 1.f};
#pragma unroll
    for (int m = 0; m < MF; ++m)
#pragma unroll
        for (int n = 0; n < NF; ++n) acc[m][n] = (f32x4){0.f, 0.f, 0.f, 0.f};
    const int arow = wm * MF * 16 + l15, asw = (arow >> 1) & 7;
    const int aoff0 = arow * 128 + ((gq ^ asw) << 4), aoff1 = arow * 128 + (((4 + gq) ^ asw) << 4);
    const int brow = wn * NF * 16 + l15, bsw = (brow >> 1) & 7;
    const int boff0 = 16384 + brow * 128 + ((gq ^ bsw) << 4), boff1 = 16384 + brow * 128 + (((4 + gq) ^ bsw) << 4);
    const int asto = a_row * 128 + ((a_ch ^ ((a_row >> 1) & 7)) << 4);
    const int bst0 = 16384 + (b_ng * 4) * 128 + ((b_kg ^ ((2 * b_ng) & 7)) << 4);
    const int bst1 = 16384 + (b_ng * 4 + 2) * 128 + ((b_kg ^ ((2 * b_ng + 1) & 7)) << 4);

#define GLOAD(it) do { \
    ra0 = *(const uint4*)(ar.p[0] + (it) * 64); ra1 = *(const uint4*)(ar.p[1] + (it) * 64); ra2 = *(const uint4*)(ar.p[2] + (it) * 64); ra3 = *(const uint4*)(ar.p[3] + (it) * 64); \
    { const float* bq_ = bp + (size_t)((it) * 64) * ldb; \
      rb0 = *(const float4*)(bq_); rb1 = *(const float4*)(bq_ + (size_t)ldb); rb2 = *(const float4*)(bq_ + (size_t)2 * ldb); rb3 = *(const float4*)(bq_ + (size_t)3 * ldb); \
      rb4 = *(const float4*)(bq_ + (size_t)4 * ldb); rb5 = *(const float4*)(bq_ + (size_t)5 * ldb); rb6 = *(const float4*)(bq_ + (size_t)6 * ldb); rb7 = *(const float4*)(bq_ + (size_t)7 * ldb); } \
    if (BGAIN) { g0 = *(const float4*)(gainp + (it) * 64); g1 = *(const float4*)(gainp + (it) * 64 + 4); } } while (0)
#define GMUL(v, g) do { v.x *= (g); v.y *= (g); v.z *= (g); v.w *= (g); } while (0)
#define LSTORE(buf) do { \
    *(uint4*)((buf) + asto) = ra0; *(uint4*)((buf) + asto + 4096) = ra1; *(uint4*)((buf) + asto + 8192) = ra2; *(uint4*)((buf) + asto + 12288) = ra3; \
    if (BGAIN) { GMUL(rb0, g0.x); GMUL(rb1, g0.y); GMUL(rb2, g0.z); GMUL(rb3, g0.w); GMUL(rb4, g1.x); GMUL(rb5, g1.y); GMUL(rb6, g1.z); GMUL(rb7, g1.w); } \
    { uint4 w; \
      w.x = pack2(rb0.x, rb1.x); w.y = pack2(rb2.x, rb3.x); w.z = pack2(rb4.x, rb5.x); w.w = pack2(rb6.x, rb7.x); *(uint4*)((buf) + bst0) = w; \
      w.x = pack2(rb0.y, rb1.y); w.y = pack2(rb2.y, rb3.y); w.z = pack2(rb4.y, rb5.y); w.w = pack2(rb6.y, rb7.y); *(uint4*)((buf) + bst0 + 128) = w; \
      w.x = pack2(rb0.z, rb1.z); w.y = pack2(rb2.z, rb3.z); w.z = pack2(rb4.z, rb5.z); w.w = pack2(rb6.z, rb7.z); *(uint4*)((buf) + bst1) = w; \
      w.x = pack2(rb0.w, rb1.w); w.y = pack2(rb2.w, rb3.w); w.z = pack2(rb4.w, rb5.w); w.w = pack2(rb6.w, rb7.w); *(uint4*)((buf) + bst1 + 128) = w; } } while (0)

    GLOAD(0);
    LSTORE(smem);
    __syncthreads();
#pragma unroll 1
    for (int it = 0; it < nk; ++it) {
        unsigned char* cur = smem + (it & 1) * 32768;
        unsigned char* nxt = smem + ((it + 1) & 1) * 32768;
        if (it + 1 < nk) GLOAD(it + 1);
#pragma unroll
        for (int ks = 0; ks < 2; ++ks) {
            bf16x8 af[MF], bfr[NF];
#pragma unroll
            for (int m = 0; m < MF; ++m) af[m] = *(const bf16x8*)(cur + (ks ? aoff1 : aoff0) + m * 2048);
#pragma unroll
            for (int n = 0; n < NF; ++n) bfr[n] = *(const bf16x8*)(cur + (ks ? boff1 : boff0) + n * 2048);
#pragma unroll
            for (int m = 0; m < MF; ++m)
#pragma unroll
                for (int n = 0; n < NF; ++n) acc[m][n] = mfma16(bfr[n], af[m], acc[m][n]);
        }
        if (it == mid_it) {
#pragma unroll
            for (int m = 0; m < MF; ++m)
#pragma unroll
                for (int n = 0; n < NF; ++n) acc[m][n] *= midscale[m];
        }
        if (it + 1 < nk) LSTORE(nxt);
        __syncthreads();
    }
#undef GLOAD
#undef LSTORE
#undef GMUL
}

__device__ void phase0(const Params& p, unsigned char* smem) {
    const int tid = threadIdx.x;
    for (int u = blockIdx.x; u < 97; u += gridDim.x) {
        if (u < 96) {
            float* sc = (float*)smem;
            for (int i = tid; i < 5 * 1024; i += 256) {
                const int r = i >> 10, k = i & 1023;
                const float v = r < 4 ? p.c[r * 1024 + k] : p.c_ctx[k];
                sc[i] = v / (1.f + expf(-v));
            }
            __syncthreads();
            const int cg4 = tid & 15, ks = tid >> 4;
            const int n0 = u * 64 + cg4 * 4;
            float4 a0 = {0, 0, 0, 0}, a1 = a0, a2 = a0, a3 = a0, a4 = a0;
            for (int kk = 0; kk < 64; ++kk) {
                const int k = ks * 64 + kk;
                const float4 w = *(const float4*)(p.w_ada + (size_t)k * 6144 + n0);
                const float s0 = sc[k], s1 = sc[1024 + k], s2 = sc[2048 + k], s3 = sc[3072 + k], s4 = sc[4096 + k];
                a0.x += s0 * w.x; a0.y += s0 * w.y; a0.z += s0 * w.z; a0.w += s0 * w.w;
                a1.x += s1 * w.x; a1.y += s1 * w.y; a1.z += s1 * w.z; a1.w += s1 * w.w;
                a2.x += s2 * w.x; a2.y += s2 * w.y; a2.z += s2 * w.z; a2.w += s2 * w.w;
                a3.x += s3 * w.x; a3.y += s3 * w.y; a3.z += s3 * w.z; a3.w += s3 * w.w;
                a4.x += s4 * w.x; a4.y += s4 * w.y; a4.z += s4 * w.z; a4.w += s4 * w.w;
            }
            float4* red = (float4*)(smem + 20480);
            red[(ks * 5 + 0) * 16 + cg4] = a0; red[(ks * 5 + 1) * 16 + cg4] = a1; red[(ks * 5 + 2) * 16 + cg4] = a2;
            red[(ks * 5 + 3) * 16 + cg4] = a3; red[(ks * 5 + 4) * 16 + cg4] = a4;
            __syncthreads();
            if (tid < 80) {
                const int r = tid >> 4, g = tid & 15;
                float4 s = {0, 0, 0, 0};
                for (int k2 = 0; k2 < 16; ++k2) { const float4 v = red[(k2 * 5 + r) * 16 + g]; s.x += v.x; s.y += v.y; s.z += v.z; s.w += v.w; }
                const int n = u * 64 + g * 4;
                const float4 bb = *(const float4*)(p.b_ada + n);
                s.x += bb.x; s.y += bb.y; s.z += bb.z; s.w += bb.w;
                *(float4*)(p.mod + r * 6144 + n) = s;
            }
            __syncthreads();
        } else {
            for (int idx = tid; idx < 2048; idx += 256) {
                const int pos = idx >> 4, i = idx & 15;
                double f = 1.0;
                for (int q = 0; q < i; ++q) f *= 0.56234132519034908;
                const double ang = (double)pos * f;
                const double twopi = 6.283185307179586476925286766559;
                const double nn = rint(ang / twopi);
                const double r = ang - nn * twopi, r2 = r * r;
                double s = r, term = r, cc = 1.0, termc = 1.0;
                for (int q = 1; q <= 14; ++q) {
                    term *= -r2 / (double)((2 * q) * (2 * q + 1)); s += term;
                    termc *= -r2 / (double)((2 * q - 1) * (2 * q)); cc += termc;
                }
                p.rope[idx] = make_float2((float)cc, (float)s);
            }
            if (tid < NE) p.gcount[tid] = 0;
            for (int k = tid; k < 1024; k += 256) p.gain_out[k] = k < 512 ? p.ona[k] : p.onb[k - 512];
        }
    }
}

__device__ void phase1a(const Params& p) {
    const int lane = threadIdx.x & 63, wid = threadIdx.x >> 6;
    const int nw = gridDim.x * 4;
    for (int R = blockIdx.x * 4 + wid; R < MR; R += nw) {
        const int b = R / TT, t = R - b * TT;
        const float* src = t < SEQ ? p.x + (size_t)(b * SEQ + t) * D : p.ctx + (size_t)(b * CTXL + t - SEQ) * D;
        const float* md = p.mod + (t < SEQ ? b : 4) * 6144;
        float4 v[4]; float ss = 0.f;
#pragma unroll
        for (int i = 0; i < 4; ++i) { v[i] = *(const float4*)(src + i * 256 + lane * 4); ss += v[i].x * v[i].x + v[i].y * v[i].y + v[i].z * v[i].z + v[i].w * v[i].w; }
        ss = wave_sum(ss);
        const float rstd = 1.0f / sqrtf(ss * (1.0f / 1024.0f) + EPS);
#pragma unroll
        for (int i = 0; i < 4; ++i) {
            const int k = i * 256 + lane * 4;
            const float4 n1 = *(const float4*)(p.norm1 + k), sh = *(const float4*)(md + k), sc = *(const float4*)(md + 1024 + k);
            f32x4 o;
            o[0] = (v[i].x * rstd * n1.x) * (1.f + sc.x) + sh.x; o[1] = (v[i].y * rstd * n1.y) * (1.f + sc.y) + sh.y;
            o[2] = (v[i].z * rstd * n1.z) * (1.f + sc.z) + sh.z; o[3] = (v[i].w * rstd * n1.w) * (1.f + sc.w) + sh.w;
            *(uint2*)(p.h + (size_t)R * D + k) = pack4(o);
        }
    }
}

__device__ void phase1b(const Params& p, unsigned char* smem) {
    const int tid = threadIdx.x, lane = tid & 63, wid = tid >> 6, l15 = lane & 15, gq = lane >> 4;
    const int wm = wid >> 1, wn = wid & 1;
    const int a_row = tid >> 3, a_ch = tid & 7, b_ng = tid & 31, b_kg = tid >> 5;
    const int nunits = 264 * 18;
    for (int u = blockIdx.x; u < nunits; u += gridDim.x) {
        const int mt = u / 18, nt = u - mt * 18;
        const int b = mt / 66, t0 = (mt - b * 66) * 128;
        const bool isctx = t0 >= SEQ;
        const bool isq = (nt < 4) || (nt >= 6 && nt < 10);
        if (isctx && isq) continue;
        ARows ar;
#pragma unroll
        for (int i = 0; i < 4; ++i) ar.p[i] = p.h + (size_t)(mt * 128 + a_row + 32 * i) * D + a_ch * 8;
        const float* bp = p.w_in + (size_t)(b_kg * 8) * INC + nt * 128 + b_ng * 4;
        f32x4 acc[4][4];
        const float ms[4] = {1.f, 1.f, 1.f, 1.f};
        gemm_mainloop<2, 2, 4, 4, false>(smem, ar, bp, INC, nullptr, 16, acc, -1, ms);
        const bool isv = (nt == 5) || (nt >= 14);
        if (!isv) {
            const float* gain; bf16_t* dst; int ld; int head; bool rope;
            if (nt < 4) { gain = p.qna; head = nt * 2 + wn; dst = p.qa; ld = 512; rope = true; }
            else if (nt == 4) { gain = p.kna; head = wn; dst = p.ka; ld = 128; rope = true; }
            else if (nt < 10) { gain = p.qnb; head = (nt - 6) * 2 + wn; dst = p.qb; ld = 512; rope = false; }
            else { gain = p.knb; head = (nt - 10) * 2 + wn; dst = p.kb; ld = 512; rope = false; }
            if (isctx) rope = false;
            f32x4 gv[4];
#pragma unroll
            for (int n = 0; n < 4; ++n) { const float4 g = *(const float4*)(gain + n * 16 + gq * 4); gv[n] = (f32x4){g.x, g.y, g.z, g.w}; }
#pragma unroll
            for (int m = 0; m < 4; ++m) {
                float ss = 0.f;
#pragma unroll
                for (int n = 0; n < 4; ++n) ss += acc[m][n][0] * acc[m][n][0] + acc[m][n][1] * acc[m][n][1] + acc[m][n][2] * acc[m][n][2] + acc[m][n][3] * acc[m][n][3];
                ss += __shfl_xor(ss, 16); ss += __shfl_xor(ss, 32);
                const float rstd = 1.0f / sqrtf(ss * (1.0f / 64.0f) + EPS);
                f32x4 y[4];
#pragma unroll
                for (int n = 0; n < 4; ++n) y[n] = acc[m][n] * rstd * gv[n];
                const int tl = t0 + wm * 64 + m * 16 + l15;
                if (rope) {
                    const int rp = tl >> 6, cp = tl & 63;
                    const float4 ra0 = *(const float4*)(p.rope + rp * 16 + gq * 4), ra1 = *(const float4*)(p.rope + rp * 16 + gq * 4 + 2);
                    const float4 ca0 = *(const float4*)(p.rope + cp * 16 + gq * 4), ca1 = *(const float4*)(p.rope + cp * 16 + gq * 4 + 2);
                    const float rc[4] = {ra0.x, ra0.z, ra1.x, ra1.z}, rs[4] = {ra0.y, ra0.w, ra1.y, ra1.w};
                    const float cc[4] = {ca0.x, ca0.z, ca1.x, ca1.z}, cs[4] = {ca0.y, ca0.w, ca1.y, ca1.w};
#pragma unroll
                    for (int r = 0; r < 4; ++r) {
                        const float x1 = y[0][r], x2 = y[1][r];
                        y[0][r] = x1 * rc[r] - x2 * rs[r]; y[1][r] = x1 * rs[r] + x2 * rc[r];
                        const float x3 = y[2][r], x4 = y[3][r];
                        y[2][r] = x3 * cc[r] - x4 * cs[r]; y[3][r] = x3 * cs[r] + x4 * cc[r];
                    }
                }
                bf16_t* rowp = dst + (size_t)(b * TT + tl) * ld + head * 64 + gq * 4;
#pragma unroll
                for (int n = 0; n < 4; ++n) *(uint2*)(rowp + n * 16) = pack4(y[n]);
            }
        } else {
            bf16_t* vb;
            if (nt == 5) vb = p.vta + (size_t)((b * 2 + wn) * 64) * TT;
            else vb = p.vtb + (size_t)((b * 8 + (nt - 14) * 2 + wn) * 64) * TT;
#pragma unroll
            for (int m = 0; m < 4; ++m) {
                const int tl = t0 + wm * 64 + m * 16 + l15;
#pragma unroll
                for (int n = 0; n < 4; ++n) {
                    const uint2 w = pack4(acc[m][n]);
                    bf16_t* q = vb + (size_t)(n * 16 + gq * 4) * TT + tl;
                    q[0] = (bf16_t)(w.x & 0xffff); q[TT] = (bf16_t)(w.x >> 16); q[2 * TT] = (bf16_t)(w.y & 0xffff); q[3 * TT] = (bf16_t)(w.y >> 16);
                }
            }
        }
    }
}

template <int NQ, int NKF, int MODE>
__device__ __forceinline__ void attn_tile(const unsigned char* kb_, const unsigned char* vb_, int koff, const bf16x8 (&qf)[NQ][2],
                                          float (&mrun)[NQ], float (&lpart)[NQ], f32x4 (&o)[NQ][4], int l15, int gq,
                                          int qpos0, int kpos0, int qcol, int wstart, const float* biasrow) {
    f32x4 s[NQ][NKF];
    const int krow = koff + l15, ksw = (krow >> 1) & 7;
    const int kad0 = krow * 128 + ((gq ^ ksw) << 4), kad1 = krow * 128 + (((4 + gq) ^ ksw) << 4);
#pragma unroll
    for (int q = 0; q < NQ; ++q)
#pragma unroll
        for (int kf = 0; kf < NKF; ++kf) s[q][kf] = (f32x4){0.f, 0.f, 0.f, 0.f};
#pragma unroll
    for (int kf = 0; kf < NKF; ++kf)
#pragma unroll
        for (int ks = 0; ks < 2; ++ks) {
            const bf16x8 kfr = *(const bf16x8*)(kb_ + (ks ? kad1 : kad0) + kf * 2048);
#pragma unroll
            for (int q = 0; q < NQ; ++q) s[q][kf] = mfma16(kfr, qf[q][ks], s[q][kf]);
        }
    bf16x8 pb[NQ][NKF / 2];
#pragma unroll
    for (int q = 0; q < NQ; ++q) {
        float tmax = -1e30f;
#pragma unroll
        for (int kf = 0; kf < NKF; ++kf)
#pragma unroll
            for (int r = 0; r < 4; ++r) {
                float xv = s[q][kf][r] * 0.125f;
                bool valid = true;
                if (MODE == 1) { const int d = (qpos0 + q * 16) - (kpos0 + kf * 16 + gq * 4 + r); valid = (d <= 128) && (d >= -128); }
                if (MODE == 2) {
                    const int kc = koff + kf * 16 + gq * 4 + r; valid = (kc >= wstart) && (kc < wstart + 16);
                    int bi = kc - qcol + 15; bi = bi < 0 ? 0 : (bi > 30 ? 30 : bi);
                    xv += biasrow[bi];
                }
                xv = valid ? xv : -1e30f;
                s[q][kf][r] = xv; tmax = fmaxf(tmax, xv);
            }
        tmax = fmaxf(tmax, __shfl_xor(tmax, 16)); tmax = fmaxf(tmax, __shfl_xor(tmax, 32));
        const float mnew = fmaxf(mrun[q], tmax);
        const float alpha = __builtin_amdgcn_exp2f((mrun[q] - mnew) * L2E);
        mrun[q] = mnew;
        float ls = 0.f;
#pragma unroll
        for (int kf = 0; kf < NKF; ++kf)
#pragma unroll
            for (int r = 0; r < 4; ++r) {
                const float xv = s[q][kf][r];
                const float pv = (xv > -5e29f) ? __builtin_amdgcn_exp2f((xv - mnew) * L2E) : 0.f;
                ls += pv; s[q][kf][r] = pv;
            }
        lpart[q] = lpart[q] * alpha + ls;
#pragma unroll
        for (int df = 0; df < 4; ++df) o[q][df] *= alpha;
#pragma unroll
        for (int t = 0; t < NKF / 2; ++t) {
            uint4 w; w.x = pack2(s[q][2 * t][0], s[q][2 * t][1]); w.y = pack2(s[q][2 * t][2], s[q][2 * t][3]);
            w.z = pack2(s[q][2 * t + 1][0], s[q][2 * t + 1][1]); w.w = pack2(s[q][2 * t + 1][2], s[q][2 * t + 1][3]);
            pb[q][t] = __builtin_bit_cast(bf16x8, w);
        }
    }
#pragma unroll
    for (int t = 0; t < NKF / 2; ++t) {
        const int vsw = (l15 >> 1) & 7;
        const int ko = koff + 32 * t + 4 * gq, ko2 = ko + 16;
        const int vlo = l15 * 128 + (((ko >> 3) ^ vsw) << 4) + ((ko & 4) << 1);
        const int vhi = l15 * 128 + (((ko2 >> 3) ^ vsw) << 4) + ((ko2 & 4) << 1);
#pragma unroll
        for (int df = 0; df < 4; ++df) {
            const uint2 lo = *(const uint2*)(vb_ + vlo + df * 2048);
            const uint2 hi = *(const uint2*)(vb_ + vhi + df * 2048);
            uint4 w; w.x = lo.x; w.y = lo.y; w.z = hi.x; w.w = hi.y;
            const bf16x8 vfr = __builtin_bit_cast(bf16x8, w);
#pragma unroll
            for (int q = 0; q < NQ; ++q) o[q][df] = mfma16(vfr, pb[q][t], o[q][df]);
        }
    }
}

template <bool ISA>
__device__ __forceinline__ void attn_unit(const Params& p, unsigned char* smem, int b, int hh, int blk) {
    constexpr int NQ = ISA ? 2 : 1;
    const int tid = threadIdx.x, lane = tid & 63, wid = tid >> 6, l15 = lane & 15, gq = lane >> 4;
    int nl, tbase;
    if (ISA) {
        const int start = blk * 128;
        const int j0 = start >= 128 ? 0 : 2, j1 = (start + 256 <= SEQ) ? 6 : 4;
        nl = j1 - j0; tbase = start - 128 + 64 * j0;
    } else {
        int rs = blk - 4; rs = rs < 0 ? 0 : (rs > 120 ? 120 : rs);
        nl = 8; tbase = rs * 64;
    }
    const int ntile = nl + 4;
    const bf16_t* kbase; const bf16_t* vbase; int ldk;
    if (ISA) { const int g = hh >> 2; kbase = p.ka + (size_t)(b * TT) * 128 + g * 64; ldk = 128; vbase = p.vta + (size_t)((b * 2 + g) * 64) * TT; }
    else { kbase = p.kb + (size_t)(b * TT) * 512 + hh * 64; ldk = 512; vbase = p.vtb + (size_t)((b * 8 + hh) * 64) * TT; }
    float* rpbl = (float*)(smem + 32768);
    if (!ISA) { for (int i = tid; i < 465; i += 256) rpbl[i] = p.rpb[hh * 465 + i]; }
    const int qt0 = ISA ? blk * 128 + wid * 32 : blk * 64 + wid * 16;
    bf16x8 qf[NQ][2];
    {
        const bf16_t* qsrc = ISA ? p.qa : p.qb;
#pragma unroll
        for (int q = 0; q < NQ; ++q)
#pragma unroll
            for (int ks = 0; ks < 2; ++ks)
                qf[q][ks] = *(const bf16x8*)(qsrc + (size_t)(b * TT + qt0 + q * 16 + l15) * 512 + hh * 64 + ks * 32 + gq * 8);
    }
    float mrun[NQ], lpart[NQ]; f32x4 o[NQ][4];
#pragma unroll
    for (int q = 0; q < NQ; ++q) {
        if (ISA) { mrun[q] = p.sink[hh]; lpart[q] = gq == 0 ? 1.f : 0.f; } else { mrun[q] = -1e30f; lpart[q] = 0.f; }
#pragma unroll
        for (int df = 0; df < 4; ++df) o[q][df] = (f32x4){0.f, 0.f, 0.f, 0.f};
    }
    const int qcol = wid * 16 + l15;
    int cs = wid * 16 - 8; cs = cs < 0 ? 0 : (cs > 32 ? 32 : cs);
    int wstart = qcol - 8; wstart = wstart < 0 ? 0 : (wstart > 48 ? 48 : wstart);
    const int r0 = tid >> 3, ch = tid & 7;
    uint4 kr0, kr1, vr0, vr1;
#define ALOAD(ti) do { const int t0_ = (ti) < nl ? tbase + 64 * (ti) : SEQ + 64 * ((ti) - nl); \
    kr0 = *(const uint4*)(kbase + (size_t)(t0_ + r0) * ldk + ch * 8); kr1 = *(const uint4*)(kbase + (size_t)(t0_ + r0 + 32) * ldk + ch * 8); \
    vr0 = *(const uint4*)(vbase + (size_t)(r0) * TT + t0_ + ch * 8); vr1 = *(const uint4*)(vbase + (size_t)(r0 + 32) * TT + t0_ + ch * 8); } while (0)
#define ASTORE(bi) do { *(uint4*)(smem + (bi) * 8192 + swz(r0, ch)) = kr0; *(uint4*)(smem + (bi) * 8192 + swz(r0 + 32, ch)) = kr1; \
    *(uint4*)(smem + 16384 + (bi) * 8192 + swz(r0, ch)) = vr0; *(uint4*)(smem + 16384 + (bi) * 8192 + swz(r0 + 32, ch)) = vr1; } while (0)
    ALOAD(0);
    ASTORE(0);
    __syncthreads();
#pragma unroll 1
    for (int ti = 0; ti < ntile; ++ti) {
        if (ti + 1 < ntile) ALOAD(ti + 1);
        const unsigned char* kb_ = smem + (ti & 1) * 8192;
        const unsigned char* vb_ = smem + 16384 + (ti & 1) * 8192;
        if (ti < nl) {
            const int t0 = tbase + 64 * ti;
            if (ISA) {
                const bool skip = (t0 > qt0 + 31 + 128) || (t0 + 63 < qt0 - 128);
                if (!skip) attn_tile<NQ, 4, 1>(kb_, vb_, 0, qf, mrun, lpart, o, l15, gq, qt0 + l15, t0, 0, 0, nullptr);
            } else {
                const int kr_ = t0 >> 6;
                const int dr = kr_ - blk + 7;
                attn_tile<NQ, 2, 2>(kb_, vb_, cs, qf, mrun, lpart, o, l15, gq, 0, 0, qcol, wstart, rpbl + dr * 31);
            }
        } else {
            attn_tile<NQ, 4, 0>(kb_, vb_, 0, qf, mrun, lpart, o, l15, gq, 0, 0, 0, 0, nullptr);
        }
        if (ti + 1 < ntile) ASTORE((ti + 1) & 1);
        __syncthreads();
    }
#undef ALOAD
#undef ASTORE
#pragma unroll
    for (int q = 0; q < NQ; ++q) {
        float lt = lpart[q]; lt += __shfl_xor(lt, 16); lt += __shfl_xor(lt, 32);
        const float inv = 1.0f / lt;
        float ssq = 0.f;
#pragma unroll
        for (int df = 0; df < 4; ++df) { o[q][df] *= inv; ssq += o[q][df][0] * o[q][df][0] + o[q][df][1] * o[q][df][1] + o[q][df][2] * o[q][df][2] + o[q][df][3] * o[q][df][3]; }
        ssq += __shfl_xor(ssq, 16); ssq += __shfl_xor(ssq, 32);
        const size_t lr = (size_t)b * SEQ + qt0 + q * 16 + l15;
        if (gq == 0) p.osq[lr * 16 + (ISA ? hh : 8 + hh)] = ssq;
        bf16_t* op = p.o + lr * 1024 + (ISA ? 0 : 512) + hh * 64 + gq * 4;
#pragma unroll
        for (int df = 0; df < 4; ++df) *(uint2*)(op + df * 16) = pack4(o[q][df]);
    }
}

__device__ void phase2(const Params& p, unsigned char* smem) {
    const int nunits = 2048 + 4096;
    for (int u = blockIdx.x; u < nunits; u += gridDim.x) {
        if (u < 2048) {
            const int hh = u & 7, blk = (u >> 3) & 63, b = u >> 9;
            attn_unit<true>(p, smem, b, hh, blk);
        } else {
            const int v = u - 2048;
            const int blk = v & 127, hh = (v >> 7) & 7, b = v >> 10;
            attn_unit<false>(p, smem, b, hh, blk);
        }
    }
}

__device__ void phase3(const Params& p, unsigned char* smem) {
    const int tid = threadIdx.x, lane = tid & 63, wid = tid >> 6, l15 = lane & 15, gq = lane >> 4;
    const int wm = wid >> 1, wn = wid & 1;
    const int a_row = tid >> 3, a_ch = tid & 7, b_ng = tid & 31, b_kg = tid >> 5;
    const int nunits = 256 * 8;
    for (int u = blockIdx.x; u < nunits; u += gridDim.x) {
        const int mt = u >> 3, nt = u & 7;
        const int b = mt >> 6;
        ARows ar;
#pragma unroll
        for (int i = 0; i < 4; ++i) ar.p[i] = p.o + (size_t)(mt * 128 + a_row + 32 * i) * D + a_ch * 8;
        const float* bp = p.w_out + (size_t)(b_kg * 8) * D + nt * 128 + b_ng * 4;
        const float* gp = p.gain_out + b_kg * 8;
        float ms[4], fs[4];
#pragma unroll
        for (int m = 0; m < 4; ++m) {
            const size_t row = (size_t)mt * 128 + wm * 64 + m * 16 + l15;
            const float4 s0 = *(const float4*)(p.osq + row * 16), s1 = *(const float4*)(p.osq + row * 16 + 4);
            const float4 s2 = *(const float4*)(p.osq + row * 16 + 8), s3 = *(const float4*)(p.osq + row * 16 + 12);
            const float sa = (s0.x + s0.y + s0.z + s0.w) + (s1.x + s1.y + s1.z + s1.w);
            const float sb = (s2.x + s2.y + s2.z + s2.w) + (s3.x + s3.y + s3.z + s3.w);
            const float ra = 1.0f / sqrtf(sa * (1.0f / 512.0f) + EPS), rb = 1.0f / sqrtf(sb * (1.0f / 512.0f) + EPS);
            ms[m] = ra / rb; fs[m] = rb;
        }
        f32x4 acc[4][4];
        gemm_mainloop<2, 2, 4, 4, true>(smem, ar, bp, D, gp, 16, acc, 7, ms);
        const float* g1p = p.mod + b * 6144 + 2048;
#pragma unroll
        for (int m = 0; m < 4; ++m) {
            const size_t row = (size_t)mt * 128 + wm * 64 + m * 16 + l15;
            float ss = 0.f;
#pragma unroll
            for (int n = 0; n < 4; ++n) {
                const int col = nt * 128 + wn * 64 + n * 16 + gq * 4;
                const float4 xv = *(const float4*)(p.x + row * D + col);
                const float4 g1 = *(const float4*)(g1p + col);
                float4 r;
                r.x = xv.x + g1.x * (acc[m][n][0] * fs[m]); r.y = xv.y + g1.y * (acc[m][n][1] * fs[m]);
                r.z = xv.z + g1.z * (acc[m][n][2] * fs[m]); r.w = xv.w + g1.w * (acc[m][n][3] * fs[m]);
                ss += r.x * r.x + r.y * r.y + r.z * r.z + r.w * r.w;
                *(float4*)(p.out + row * D + col) = r;
            }
            ss += __shfl_xor(ss, 16); ss += __shfl_xor(ss, 32);
            if (gq == 0) p.st2[row * 16 + nt * 2 + wn] = ss;
        }
    }
}

__device__ void phase4a(const Params& p) {
    const int lane = threadIdx.x & 63, wid = threadIdx.x >> 6;
    const int nw = gridDim.x * 4;
    for (int R = blockIdx.x * 4 + wid; R < NLAT; R += nw) {
        const int b = R >> 13;
        const float* md = p.mod + b * 6144;
        float sv = lane < 16 ? p.st2[(size_t)R * 16 + lane] : 0.f;
        sv = wave_sum(sv);
        const float rstd = 1.0f / sqrtf(sv * (1.0f / 1024.0f) + EPS);
        const float* src = p.out + (size_t)R * D;
#pragma unroll
        for (int i = 0; i < 4; ++i) {
            const int k = i * 256 + lane * 4;
            const float4 v = *(const float4*)(src + k);
            const float4 n2 = *(const float4*)(p.norm2 + k), sh = *(const float4*)(md + 3072 + k), sc = *(const float4*)(md + 4096 + k);
            f32x4 o;
            o[0] = (v.x * rstd * n2.x) * (1.f + sc.x) + sh.x; o[1] = (v.y * rstd * n2.y) * (1.f + sc.y) + sh.y;
            o[2] = (v.z * rstd * n2.z) * (1.f + sc.z) + sh.z; o[3] = (v.w * rstd * n2.w) * (1.f + sc.w) + sh.w;
            *(uint2*)(p.h2 + (size_t)R * D + k) = pack4(o);
        }
    }
}

__device__ __forceinline__ float silu_f(float v) { return v / (1.f + __expf(-v)); }

template <class SlotF>
__device__ __forceinline__ void swiglu_unit(unsigned char* smem, const ARows& ar, const float* wg, const float* wu, int j, bf16_t* act, SlotF slotf) {
    const int tid = threadIdx.x, lane = tid & 63, wid = tid >> 6, l15 = lane & 15, gq = lane >> 4;
    const int b_ng = tid & 31, b_kg = tid >> 5;
    const int n0 = b_ng * 4;
    const float* bp = (n0 < 64 ? wg + j * 64 + n0 : wu + j * 64 + (n0 - 64)) + (size_t)(b_kg * 8) * 256;
    f32x4 acc[2][8];
    const float ms[2] = {1.f, 1.f};
    gemm_mainloop<4, 1, 2, 8, false>(smem, ar, bp, 256, nullptr, 16, acc, -1, ms);
#pragma unroll
    for (int m = 0; m < 2; ++m) {
        const int rowl = wid * 32 + m * 16 + l15;
        const long slot = slotf(rowl);
        if (slot >= 0) {
            bf16_t* dst = act + (size_t)slot * 256 + j * 64 + gq * 4;
#pragma unroll
            for (int n = 0; n < 4; ++n) {
                f32x4 v;
#pragma unroll
                for (int r = 0; r < 4; ++r) v[r] = silu_f(acc[m][n][r]) * acc[m][n + 4][r];
                *(uint2*)(dst + n * 16) = pack4(v);
            }
        }
    }
}

__device__ void router_unit(const Params& p, unsigned char* smem, int mt) {
    const int tid = threadIdx.x, lane = tid & 63, wid = tid >> 6, l15 = lane & 15, gq = lane >> 4;
    const int wm = wid >> 1, wn = wid & 1;
    const int a_row = tid >> 3, a_ch = tid & 7, b_ng = tid & 31, b_kg = tid >> 5;
    ARows ar;
#pragma unroll
    for (int i = 0; i < 4; ++i) ar.p[i] = p.h2 + (size_t)(mt * 128 + a_row + 32 * i) * D + a_ch * 8;
#pragma unroll 1
    for (int nt = 0; nt < 2; ++nt) {
        const float* bp = p.w_router + (size_t)(b_kg * 8) * 256 + nt * 128 + b_ng * 4;
        f32x4 acc[4][4];
        const float ms[4] = {1.f, 1.f, 1.f, 1.f};
        gemm_mainloop<2, 2, 4, 4, false>(smem, ar, bp, 256, nullptr, 16, acc, -1, ms);
#pragma unroll
        for (int m = 0; m < 4; ++m) {
            const size_t row = (size_t)mt * 128 + wm * 64 + m * 16 + l15;
#pragma unroll
            for (int n = 0; n < 4; ++n) {
                float4 v = {acc[m][n][0], acc[m][n][1], acc[m][n][2], acc[m][n][3]};
                *(float4*)(p.logits + row * 256 + nt * 128 + wn * 64 + n * 16 + gq * 4) = v;
            }
        }
    }
    int* lcnt = (int*)smem;
    int* lbase = (int*)(smem + 1024);
    int* sel_e = (int*)(smem + 2048);
    int* sel_p = (int*)(smem + 2048 + 4096);
    __syncthreads();
    lcnt[tid] = 0;
    __syncthreads();
    const float4 bias4 = *(const float4*)(p.rbias + lane * 4);
#pragma unroll 1
    for (int tl = wid * 32; tl < wid * 32 + 32; ++tl) {
        const size_t tok = (size_t)mt * 128 + tl;
        const float4 lg = *(const float4*)(p.logits + tok * 256 + lane * 4);
        const float s0 = 1.f / (1.f + expf(-lg.x)), s1 = 1.f / (1.f + expf(-lg.y)), s2 = 1.f / (1.f + expf(-lg.z)), s3 = 1.f / (1.f + expf(-lg.w));
        float c0 = s0 + bias4.x, c1 = s1 + bias4.y, c2 = s2 + bias4.z, c3 = s3 + bias4.w;
        float a = fmaxf(c0, c1), bmin = fminf(c0, c1), cmx = fmaxf(c2, c3), dmin = fminf(c2, c3);
        float t1 = fmaxf(a, cmx), t2 = fmaxf(fminf(a, cmx), fmaxf(bmin, dmin));
#pragma unroll
        for (int off = 1; off <= 4; off <<= 1) {
            const float o1 = __shfl_xor(t1, off), o2 = __shfl_xor(t2, off);
            const float n1 = fmaxf(t1, o1), n2 = fmaxf(fminf(t1, o1), fmaxf(t2, o2));
            t1 = n1; t2 = n2;
        }
        const float gs = t1 + t2;
        const int g = lane >> 3;
        int rank = 0;
#pragma unroll
        for (int g2 = 0; g2 < 8; ++g2) { const float og = __shfl(gs, g2 * 8); rank += (og > gs || (og == gs && g2 < g)) ? 1 : 0; }
        if (rank >= 4) { c0 = -1e30f; c1 = -1e30f; c2 = -1e30f; c3 = -1e30f; }
        float tsum = 0.f; float mys = 0.f; int mye = 0;
#pragma unroll
        for (int k = 0; k < 8; ++k) {
            float bv = c0; int bi = lane * 4;
            if (c1 > bv) { bv = c1; bi = lane * 4 + 1; }
            if (c2 > bv) { bv = c2; bi = lane * 4 + 2; }
            if (c3 > bv) { bv = c3; bi = lane * 4 + 3; }
#pragma unroll
            for (int off = 32; off >= 1; off >>= 1) {
                const float ov = __shfl_xor(bv, off); const int oi = __shfl_xor(bi, off);
                if (ov > bv || (ov == bv && oi < bi)) { bv = ov; bi = oi; }
            }
            const int wl = bi >> 2, wi = bi & 3;
            const float sv_l = wi == 0 ? s0 : (wi == 1 ? s1 : (wi == 2 ? s2 : s3));
            const float sv = __shfl(sv_l, wl);
            if (lane == wl) { if (wi == 0) c0 = -INFINITY; else if (wi == 1) c1 = -INFINITY; else if (wi == 2) c2 = -INFINITY; else c3 = -INFINITY; }
            tsum += sv;
            if (lane == k) { mys = sv; mye = bi; }
        }
        if (lane < 8) {
            p.gates[tok * 8 + lane] = mys / tsum * 2.5f;
            const int pos = atomicAdd(&lcnt[mye], 1);
            sel_e[tl * 8 + lane] = mye; sel_p[tl * 8 + lane] = pos;
        }
    }
    __syncthreads();
    { const int cnt = lcnt[tid]; lbase[tid] = cnt > 0 ? atomicAdd(&p.gcount[tid], cnt) : 0; }
    __syncthreads();
    for (int i = tid; i < 1024; i += 256) {
        const int e = sel_e[i], pos = sel_p[i];
        const int tl = i >> 3, k = i & 7;
        p.lists[(size_t)e * NLAT + lbase[e] + pos] = (mt * 128 + tl) * 8 + k;
    }
    __syncthreads();
}

__device__ void phase4b(const Params& p, unsigned char* smem) {
    const int tid = threadIdx.x;
    const int a_row = tid >> 3, a_ch = tid & 7;
    const int nunits = 256 + 1024;
    for (int u = blockIdx.x; u < nunits; u += gridDim.x) {
        if (u < 256) router_unit(p, smem, u);
        else {
            const int v = u - 256, mt = v >> 2, j = v & 3;
            ARows ar;
#pragma unroll
            for (int i = 0; i < 4; ++i) ar.p[i] = p.h2 + (size_t)(mt * 128 + a_row + 32 * i) * D + a_ch * 8;
            swiglu_unit(smem, ar, p.ws_gate, p.ws_up, j, p.act, [&](int rowl) -> long { return (long)NLAT * 8 + mt * 128 + rowl; });
        }
    }
}

struct XMap { int x, lb, nlb; int* pref; };

__device__ __forceinline__ XMap xmap_build(const Params& p, unsigned char* smem_tail) {
    XMap m; m.x = blockIdx.x & 7; m.lb = blockIdx.x >> 3; m.nlb = (gridDim.x - m.x + 7) >> 3; m.pref = (int*)smem_tail;
    __syncthreads();
    if (threadIdx.x == 0) {
        int s = 0; m.pref[0] = 0;
        for (int i = 0; i < 32; ++i) { const int c = p.gcount[m.x + 8 * i]; s += (c + 127) >> 7; m.pref[i + 1] = s; }
    }
    __syncthreads();
    return m;
}
__device__ __forceinline__ void xmap_find(const XMap& m, int tix, int& e, int& ti) {
    int lo = 0;
#pragma unroll
    for (int step = 16; step >= 1; step >>= 1) if (m.pref[lo + step] <= tix) lo += step;
    e = m.x + 8 * lo; ti = tix - m.pref[lo];
}

__device__ void phase5a(const Params& p, unsigned char* smem) {
    const int tid = threadIdx.x, lane = tid & 63, wid = tid >> 6, l15 = lane & 15, gq = lane >> 4;
    const int wm = wid >> 1, wn = wid & 1;
    const int a_row = tid >> 3, a_ch = tid & 7, b_ng = tid & 31, b_kg = tid >> 5;
    XMap xm = xmap_build(p, smem + 65536);
    const int nloc = xm.pref[32] * 4;
    for (int lu = xm.lb; lu < nloc; lu += xm.nlb) {
        int e, ti; xmap_find(xm, lu >> 2, e, ti);
        const int j = lu & 3;
        const int cnt = p.gcount[e];
        const int* lst = p.lists + (size_t)e * NLAT + ti * 128;
        const int nrow = cnt - ti * 128;
        ARows ar;
#pragma unroll
        for (int i = 0; i < 4; ++i) {
            const int r = a_row + 32 * i;
            const int slot = r < nrow ? lst[r] : 0;
            ar.p[i] = p.h2 + (size_t)(slot >> 3) * D + a_ch * 8;
        }
        swiglu_unit(smem, ar, p.we_gate + (size_t)e * 262144, p.we_up + (size_t)e * 262144, j, p.act,
                    [&](int rowl) -> long { return rowl < nrow ? (long)lst[rowl] : -1L; });
    }
    const int nsh = 256 * 8;
    for (int u = blockIdx.x; u < nsh; u += gridDim.x) {
        const int mt = u >> 3, nt = u & 7, b = mt >> 6;
        ARows ar;
#pragma unroll
        for (int i = 0; i < 4; ++i) ar.p[i] = p.act + ((size_t)NLAT * 8 + mt * 128 + a_row + 32 * i) * 256 + a_ch * 8;
        const float* bp = p.ws_down + (size_t)(b_kg * 8) * D + nt * 128 + b_ng * 4;
        f32x4 acc[4][4];
        const float ms[4] = {1.f, 1.f, 1.f, 1.f};
        gemm_mainloop<2, 2, 4, 4, false>(smem, ar, bp, D, nullptr, 4, acc, -1, ms);
        const float* g2p = p.mod + b * 6144 + 5120;
#pragma unroll
        for (int m = 0; m < 4; ++m) {
            const size_t row = (size_t)mt * 128 + wm * 64 + m * 16 + l15;
#pragma unroll
            for (int n = 0; n < 4; ++n) {
                const int col = nt * 128 + wn * 64 + n * 16 + gq * 4;
                float4 xv = *(const float4*)(p.out + row * D + col);
                const float4 g2 = *(const float4*)(g2p + col);
                xv.x += g2.x * acc[m][n][0]; xv.y += g2.y * acc[m][n][1]; xv.z += g2.z * acc[m][n][2]; xv.w += g2.w * acc[m][n][3];
                *(float4*)(p.out + row * D + col) = xv;
            }
        }
    }
}

__device__ void phase5b(const Params& p, unsigned char* smem) {
    const int tid = threadIdx.x, lane = tid & 63, wid = tid >> 6, l15 = lane & 15, gq = lane >> 4;
    const int wm = wid >> 1, wn = wid & 1;
    const int a_row = tid >> 3, a_ch = tid & 7, b_ng = tid & 31, b_kg = tid >> 5;
    XMap xm = xmap_build(p, smem + 65536);
    const int nloc = xm.pref[32] * 8;
    for (int lu = xm.lb; lu < nloc; lu += xm.nlb) {
        int e, ti; xmap_find(xm, lu >> 3, e, ti);
        const int nt = lu & 7;
        const int cnt = p.gcount[e];
        const int* lst = p.lists + (size_t)e * NLAT + ti * 128;
        const int nrow = cnt - ti * 128;
        ARows ar;
#pragma unroll
        for (int i = 0; i < 4; ++i) {
            const int r = a_row + 32 * i;
            const int slot = r < nrow ? lst[r] : 0;
            ar.p[i] = p.act + (size_t)slot * 256 + a_ch * 8;
        }
        const float* bp = p.we_down + (size_t)e * 262144 + (size_t)(b_kg * 8) * D + nt * 128 + b_ng * 4;
        f32x4 acc[4][4];
        const float ms[4] = {1.f, 1.f, 1.f, 1.f};
        gemm_mainloop<2, 2, 4, 4, false>(smem, ar, bp, D, nullptr, 4, acc, -1, ms);
#pragma unroll
        for (int m = 0; m < 4; ++m) {
            const int rowl = wm * 64 + m * 16 + l15;
            if (rowl < nrow) {
                const int slot = lst[rowl];
                bf16_t* dst = p.y + (size_t)slot * D + nt * 128 + wn * 64 + gq * 4;
#pragma unroll
                for (int n = 0; n < 4; ++n) *(uint2*)(dst + n * 16) = pack4(acc[m][n]);
            }
        }
    }
}

__device__ void phase6(const Params& p) {
    const int lane = threadIdx.x & 63, wid = threadIdx.x >> 6;
    const int nw = gridDim.x * 4;
    for (int R = blockIdx.x * 4 + wid; R < NLAT; R += nw) {
        const int b = R >> 13;
        const float* g2p = p.mod + b * 6144 + 5120;
        const float4 ga = *(const float4*)(p.gates + (size_t)R * 8), gb = *(const float4*)(p.gates + (size_t)R * 8 + 4);
        const float gk[8] = {ga.x, ga.y, ga.z, ga.w, gb.x, gb.y, gb.z, gb.w};
#pragma unroll
        for (int i = 0; i < 4; ++i) {
            const int col = i * 256 + lane * 4;
            float s0 = 0.f, s1 = 0.f, s2 = 0.f, s3 = 0.f;
#pragma unroll
            for (int k = 0; k < 8; ++k) {
                const uint2 w = *(const uint2*)(p.y + ((size_t)R * 8 + k) * D + col);
                s0 += gk[k] * __uint_as_float(w.x << 16); s1 += gk[k] * __uint_as_float(w.x & 0xffff0000u);
                s2 += gk[k] * __uint_as_float(w.y << 16); s3 += gk[k] * __uint_as_float(w.y & 0xffff0000u);
            }
            float4 xv = *(const float4*)(p.out + (size_t)R * D + col);
            const float4 g2 = *(const float4*)(g2p + col);
            xv.x += g2.x * s0; xv.y += g2.y * s1; xv.z += g2.z * s2; xv.w += g2.w * s3;
            *(float4*)(p.out + (size_t)R * D + col) = xv;
        }
    }
}

#define XB_TMO      128
#define XB_XCNT(j)  (256  + 64 * (j))
#define XB_XSUB(j)  (1280 + 64 * (j))
#define XB_XGEN(j)  (2304 + 64 * (j))
#define XB_TOP      3328
#define XB_TOPGEN   3392
#define XCD_BAR_WORDS 3456
#define XB_SPIN_CAP (1u << 18)
#define LAS __attribute__((address_space(3)))
__device__ __forceinline__ unsigned xb_ld(unsigned* p)              { return __hip_atomic_load(p, __ATOMIC_RELAXED, __HIP_MEMORY_SCOPE_AGENT); }
__device__ __forceinline__ unsigned xb_add(unsigned* p, unsigned v) { return __hip_atomic_fetch_add(p, v, __ATOMIC_RELAXED, __HIP_MEMORY_SCOPE_AGENT); }
__device__ __forceinline__ unsigned xb_xcc_id() { return (unsigned)__builtin_amdgcn_s_getreg((3 << 11) | 20) & 0xFu; }
#define XB_SPIN(cond, bar) do { unsigned _sp = 0; while (cond) { __builtin_amdgcn_s_sleep(1); \
    if ((++_sp & 255u) == 0u) { if (xb_ld(&(bar)[XB_TMO])) break; if (_sp > XB_SPIN_CAP) { atomicAdd(&(bar)[XB_TMO], 1u); break; } } } } while (0)
struct XcdBarrier { unsigned* bar; unsigned x; volatile LAS unsigned* st; };
__device__ __forceinline__ XcdBarrier xcd_barrier_post(unsigned* bar, volatile LAS unsigned* st) {
    XcdBarrier b; b.bar = bar; b.x = xb_xcc_id(); b.st = st;
    if (threadIdx.x == 0) (void)xb_add(&bar[XB_XCNT(b.x)], 1u);
    return b;
}
__device__ __forceinline__ void xcd_barrier_complete(unsigned* bar, unsigned x, unsigned& nloc, unsigned& nx) {
    const unsigned G = gridDim.x * gridDim.y * gridDim.z;
    unsigned sum, cnt, mine, sp = 0u;
    for (;;) {
        sum = 0u; cnt = 0u; mine = 0u;
#pragma unroll
        for (unsigned j = 0; j < 16; ++j) { const unsigned c = xb_ld(&bar[XB_XCNT(j)]); sum += c; cnt += (c > 0u) ? 1u : 0u; mine = (j == x) ? c : mine; }
        if (sum == G) break;
        __builtin_amdgcn_s_sleep(1);
        if ((++sp & 255u) == 0u) { if (xb_ld(&bar[XB_TMO])) break; if (sp > XB_SPIN_CAP) { atomicAdd(&bar[XB_TMO], 1u); break; } }
    }
    nloc = mine > 0u ? mine : 1u; nx = cnt > 0u ? cnt : 1u;
}
__device__ __forceinline__ void xcd_barrier(const XcdBarrier& b) {
    asm volatile("s_waitcnt vmcnt(0)" ::: "memory");
    __syncthreads();
    if (threadIdx.x == 0) {
        unsigned* bar = b.bar;
        __builtin_amdgcn_s_waitcnt(0);
        unsigned nloc = b.st[0], nx = b.st[1];
        if (nloc == 0u) { xcd_barrier_complete(bar, b.x, nloc, nx); b.st[0] = nloc; b.st[1] = nx; }
        const unsigned old = xb_add(&bar[XB_XSUB(b.x)], 1u);
        const unsigned gen = old / nloc;
        if (old + 1u == (gen + 1u) * nloc) {
            __builtin_amdgcn_fence(__ATOMIC_RELEASE, "agent");
            asm volatile("s_waitcnt vmcnt(0)" ::: "memory");
            const unsigned og = xb_add(&bar[XB_TOP], 1u);
            const unsigned tg = og / nx;
            if (og + 1u == (tg + 1u) * nx) xb_add(&bar[XB_TOPGEN], 1u);
            else XB_SPIN(xb_ld(&bar[XB_TOPGEN]) == tg, bar);
            __builtin_amdgcn_fence(__ATOMIC_ACQUIRE, "agent");
            xb_add(&bar[XB_XGEN(b.x)], 1u);
            asm volatile("s_waitcnt vmcnt(0)" ::: "memory");
        } else {
            XB_SPIN(xb_ld(&bar[XB_XGEN(b.x)]) == gen, bar);
            __builtin_amdgcn_fence(__ATOMIC_ACQUIRE, "agent");
            asm volatile("s_waitcnt vmcnt(0)" ::: "memory");
        }
    }
    __syncthreads();
}

constexpr size_t al256(size_t v) { return (v + 255) & ~(size_t)255; }
constexpr size_t OFF_BAR = 0;
constexpr size_t OFF_MOD = OFF_BAR + al256(XCD_BAR_WORDS * 4);
constexpr size_t OFF_ROPE = OFF_MOD + al256(5 * 6144 * 4);
constexpr size_t OFF_GCOUNT = OFF_ROPE + al256(2048 * 8);
constexpr size_t OFF_GAIN = OFF_GCOUNT + al256(256 * 4);
constexpr size_t OFF_OSQ = OFF_GAIN + al256(1024 * 4);
constexpr size_t OFF_ST2 = OFF_OSQ + al256((size_t)NLAT * 16 * 4);
constexpr size_t OFF_H2 = OFF_ST2 + al256((size_t)NLAT * 16 * 4);
constexpr size_t OFF_GATES = OFF_H2 + al256((size_t)NLAT * D * 2);
constexpr size_t OFF_LISTS = OFF_GATES + al256((size_t)NLAT * 8 * 4);
constexpr size_t OFF_ACT = OFF_LISTS + al256((size_t)NE * NLAT * 4);
constexpr size_t OFF_UNION = OFF_ACT + al256((size_t)NLAT * 9 * 256 * 2);
constexpr size_t OFF_Y = OFF_UNION;
constexpr size_t OFF_H = OFF_UNION;
constexpr size_t OFF_QA = OFF_H + al256((size_t)MR * D * 2);
constexpr size_t OFF_KA = OFF_QA + al256((size_t)MR * 512 * 2);
constexpr size_t OFF_VTA = OFF_KA + al256((size_t)MR * 128 * 2);
constexpr size_t OFF_QB = OFF_VTA + al256((size_t)NB * 2 * 64 * TT * 2);
constexpr size_t OFF_KB = OFF_QB + al256((size_t)MR * 512 * 2);
constexpr size_t OFF_VTB = OFF_KB + al256((size_t)MR * 512 * 2);
constexpr size_t OFF_O = OFF_VTB + al256((size_t)NB * 8 * 64 * TT * 2);
constexpr size_t OFF_LOGITS = OFF_O + al256((size_t)NLAT * D * 2);
constexpr size_t END_A = OFF_LOGITS + al256((size_t)NLAT * 256 * 4);
constexpr size_t END_Y = OFF_Y + (size_t)NLAT * 8 * D * 2;
constexpr size_t WS_NEED = END_A > END_Y ? END_A : END_Y;

struct KArgs { const float* in[26]; float* out; unsigned char* ws; };

__device__ __forceinline__ Params make_params(const KArgs& a) {
    Params p;
    p.x = a.in[0]; p.c = a.in[1]; p.ctx = a.in[2]; p.c_ctx = a.in[3]; p.w_ada = a.in[4]; p.b_ada = a.in[5]; p.norm1 = a.in[6]; p.norm2 = a.in[7];
    p.w_in = a.in[8]; p.qna = a.in[9]; p.kna = a.in[10]; p.qnb = a.in[11]; p.knb = a.in[12]; p.sink = a.in[13]; p.rpb = a.in[14]; p.ona = a.in[15];
    p.onb = a.in[16]; p.w_out = a.in[17]; p.w_router = a.in[18]; p.rbias = a.in[19]; p.we_gate = a.in[20]; p.we_up = a.in[21]; p.we_down = a.in[22];
    p.ws_gate = a.in[23]; p.ws_up = a.in[24]; p.ws_down = a.in[25];
    p.out = a.out;
    unsigned char* w = a.ws;
    p.mod = (float*)(w + OFF_MOD); p.rope = (float2*)(w + OFF_ROPE); p.gcount = (int*)(w + OFF_GCOUNT); p.gain_out = (float*)(w + OFF_GAIN);
    p.osq = (float*)(w + OFF_OSQ); p.st2 = (float*)(w + OFF_ST2); p.h2 = (bf16_t*)(w + OFF_H2); p.gates = (float*)(w + OFF_GATES);
    p.lists = (int*)(w + OFF_LISTS); p.act = (bf16_t*)(w + OFF_ACT); p.y = (bf16_t*)(w + OFF_Y);
    p.h = (bf16_t*)(w + OFF_H); p.qa = (bf16_t*)(w + OFF_QA); p.ka = (bf16_t*)(w + OFF_KA); p.vta = (bf16_t*)(w + OFF_VTA);
    p.qb = (bf16_t*)(w + OFF_QB); p.kb = (bf16_t*)(w + OFF_KB); p.vtb = (bf16_t*)(w + OFF_VTB); p.o = (bf16_t*)(w + OFF_O);
    p.logits = (float*)(w + OFF_LOGITS);
    return p;
}

__global__ void __launch_bounds__(256, 2) mk_fwd(KArgs ka) {
    cg::grid_group grid = cg::this_grid();
    __shared__ __attribute__((aligned(16))) unsigned char smem[65536 + 256];
    const Params p = make_params(ka);
    volatile LAS unsigned* xst = (volatile LAS unsigned*)(smem + 65536 + 192);
    if (threadIdx.x == 0) { xst[0] = 0u; xst[1] = 0u; }
    __syncthreads();
    XcdBarrier xb = xcd_barrier_post((unsigned*)(ka.ws + OFF_BAR), xst);
    phase0(p, smem);
    grid.sync();
    phase1a(p);
    xcd_barrier(xb);
    phase1b(p, smem);
    xcd_barrier(xb);
    phase2(p, smem);
    xcd_barrier(xb);
    phase3(p, smem);
    xcd_barrier(xb);
    phase4a(p);
    xcd_barrier(xb);
    phase4b(p, smem);
    xcd_barrier(xb);
    phase5a(p, smem);
    xcd_barrier(xb);
    phase5b(p, smem);
    xcd_barrier(xb);
    phase6(p);
}

extern "C" void kernel_launch(void* const* d_in, const int* in_sizes, int n_in,
                              void* d_out, int out_size, void* d_ws, size_t ws_size,
                              hipStream_t stream) {
    static int grid_blocks = 0;
    if (!grid_blocks) {
        int dev = 0, cus = 0, per_cu = 0;
        (void)hipGetDevice(&dev);
        (void)hipDeviceGetAttribute(&cus, hipDeviceAttributeMultiprocessorCount, dev);
        (void)hipOccupancyMaxActiveBlocksPerMultiprocessor(&per_cu, mk_fwd, 256, 0);
        if (per_cu > 2) per_cu = 2;
        if (per_cu < 1) per_cu = 1;
        grid_blocks = cus * per_cu;
    }
    if (WS_NEED > ws_size) { fprintf(stderr, "workspace too small: need %zu have %zu\n", (size_t)WS_NEED, ws_size); return; }
    KArgs a{};
    for (int i = 0; i < 26; ++i) a.in[i] = (const float*)d_in[i];
    a.out = (float*)d_out; a.ws = (unsigned char*)d_ws;
    (void)hipMemsetAsync((unsigned char*)d_ws + OFF_BAR, 0, XCD_BAR_WORDS * 4, stream);
    void* args[] = {&a};
    hipError_t e = hipLaunchCooperativeKernel((void*)mk_fwd, dim3(grid_blocks), dim3(256), args, 0, stream);
    if (e != hipSuccess) fprintf(stderr, "cooperative launch failed: %s (grid %d)\n", hipGetErrorString(e), grid_blocks);
}
```
